# Optimizing an MI355X kernel written in HIP

```python
import math
import jax, jax.numpy as jnp
from jax import lax
import numpy as np

D_MODEL = 2048
BATCH = 2
SEQ = 16384
DEPTH = 2

PLE_DIM = 256
EPS = 1e-6
BLOCK = 128
MLA_HEADS = 8
MLA_NOPE = 128
MLA_ROPE = 64
MLA_V = 128
Q_RANK = 384
KV_RANK = 256
ROPE_THETA = 10000.0
SWA_HEADS = 8
SWA_KV_HEADS = 2
SWA_GROUP = SWA_HEADS // SWA_KV_HEADS
HEAD_DIM = 128
WINDOW = 128
NUM_BUCKETS = 32
T5_MAX_DISTANCE = 128
D_FF = 5504
CONV_W = 3
MLA_WIDTH = MLA_HEADS * MLA_V
SWA_WIDTH = SWA_HEADS * HEAD_DIM
MIX_WIDTH = MLA_WIDTH + SWA_WIDTH
IN_SPLITS = (Q_RANK, KV_RANK, MLA_ROPE, SWA_HEADS * HEAD_DIM, SWA_KV_HEADS * HEAD_DIM, SWA_KV_HEADS * HEAD_DIM)
IN_WIDTH = sum(IN_SPLITS)
IN_OFFSETS = tuple(int(v) for v in np.cumsum(IN_SPLITS)[:-1])
NEG = -1e30

kernel_name = "hybrid_mla_swa_convglu_encoder"


def rmsnorm(x, g):
    x32 = x.astype(jnp.float32)
    y = x32 * lax.rsqrt(jnp.mean(x32 * x32, axis=-1, keepdims=True) + EPS)
    return (y * g.astype(jnp.float32)).astype(x.dtype)


def rope_tables(positions):
    inv_freq = ROPE_THETA ** (-jnp.arange(0, MLA_ROPE, 2, dtype=jnp.float32) / MLA_ROPE)
    ang = positions.astype(jnp.float32)[..., None] * inv_freq
    return jnp.cos(ang), jnp.sin(ang)


def apply_rope(t, cos, sin):
    t32 = t.astype(jnp.float32)
    t1, t2 = t32[..., : MLA_ROPE // 2], t32[..., MLA_ROPE // 2:]
    return jnp.concatenate([t1 * cos - t2 * sin, t1 * sin + t2 * cos], axis=-1).astype(t.dtype)


def t5_bucket(rel):
    half = NUM_BUCKETS // 2
    max_exact = half // 2
    ret = jnp.where(rel > 0, half, 0)
    n = jnp.abs(rel)
    nf = jnp.maximum(n, max_exact).astype(jnp.float32)
    large = max_exact + (jnp.log(nf / max_exact) / math.log(T5_MAX_DISTANCE / max_exact)
                         * (half - max_exact)).astype(jnp.int32)
    large = jnp.minimum(large, half - 1)
    return ret + jnp.where(n < max_exact, n, large)


def mla_attention(z_cq, z_ckv, z_kr, cq_norm, ckv_norm, w_uq, w_ukv, cos, sin):
    B, S = z_cq.shape[:2]
    nb = S // BLOCK
    q = (rmsnorm(z_cq, cq_norm) @ w_uq).reshape(B, S, MLA_HEADS, MLA_NOPE + MLA_ROPE)
    q_nope = q[..., :MLA_NOPE]
    q_rope = apply_rope(q[..., MLA_NOPE:], cos[:, :, None], sin[:, :, None])
    kv = (rmsnorm(z_ckv, ckv_norm) @ w_ukv).reshape(B, S, MLA_HEADS, MLA_NOPE + MLA_V)
    k_nope, v = kv[..., :MLA_NOPE], kv[..., MLA_NOPE:]
    k_rope = apply_rope(z_kr, cos, sin)
    scale = 1.0 / math.sqrt(MLA_NOPE + MLA_ROPE)
    qn_b = jnp.moveaxis(q_nope.reshape(B, nb, BLOCK, MLA_HEADS, MLA_NOPE), 1, 0)
    qr_b = jnp.moveaxis(q_rope.reshape(B, nb, BLOCK, MLA_HEADS, MLA_ROPE), 1, 0)

    def one_block(args):
        qn, qr = args
        s = (jnp.einsum('bqhd,bkhd->bhqk', qn, k_nope)
             + jnp.einsum('bqhd,bkd->bhqk', qr, k_rope)).astype(jnp.float32) * scale
        pr = jax.nn.softmax(s, axis=-1).astype(v.dtype)
        return jnp.einsum('bhqk,bkhd->bqhd', pr, v)

    o = lax.map(one_block, (qn_b, qr_b))
    return jnp.moveaxis(o, 0, 1).reshape(B, S, MLA_WIDTH)


def _neighbours(t):
    pad = [(0, 0), (1, 1)] + [(0, 0)] * (t.ndim - 2)
    tp = jnp.pad(t, pad)
    return jnp.concatenate([tp[:, :-2], tp[:, 1:-1], tp[:, 2:]], axis=2)


def swa_attention(q, k, v, positions, sink, t5_bias):
    B, S = q.shape[:2]
    nb = S // BLOCK
    qb = q.reshape(B, nb, BLOCK, SWA_KV_HEADS, SWA_GROUP, HEAD_DIM)
    kn = _neighbours(k.reshape(B, nb, BLOCK, SWA_KV_HEADS, HEAD_DIM))
    vn = _neighbours(v.reshape(B, nb, BLOCK, SWA_KV_HEADS, HEAD_DIM))
    pq = positions.reshape(B, nb, BLOCK)
    pk = _neighbours(pq)
    kidx = (jnp.arange(nb)[:, None] - 1) * BLOCK + jnp.arange(3 * BLOCK)[None, :]
    valid = (kidx >= 0) & (kidx < S)
    rel = pk[:, :, None, :] - pq[:, :, :, None]
    mask = (jnp.abs(rel) <= WINDOW) & valid[None, :, None, :]
    bias = jnp.take(t5_bias.T, t5_bucket(rel), axis=1)
    bias = bias.reshape(SWA_KV_HEADS, SWA_GROUP, B, nb, BLOCK, 3 * BLOCK).transpose(2, 3, 0, 1, 4, 5)
    scale = 1.0 / math.sqrt(HEAD_DIM)
    s = jnp.einsum('bnqhgd,bnkhd->bnhgqk', qb, kn).astype(jnp.float32) * scale + bias.astype(jnp.float32)
    s = jnp.where(mask[:, :, None, None], s, NEG)
    sk = sink.astype(jnp.float32).reshape(SWA_KV_HEADS, SWA_GROUP)[None, None, :, :, None, None]
    m = jnp.maximum(jnp.max(s, axis=-1, keepdims=True), sk)
    e = jnp.exp(s - m)
    pr = e / (jnp.sum(e, axis=-1, keepdims=True) + jnp.exp(sk - m))
    o = jnp.einsum('bnhgqk,bnkhd->bnqhgd', pr.astype(v.dtype), vn)
    return o.reshape(B, S, SWA_WIDTH)


def depthwise_conv3(t, w, b):
    tp = jnp.pad(t, ((0, 0), (1, 1), (0, 0)))
    return tp[:, :-2] * w[0] + tp[:, 1:-1] * w[1] + tp[:, 2:] * w[2] + b


def setup_inputs(seed: int = 0) -> dict:
    key = jax.random.key(seed)
    ks = iter(jax.random.split(key, 32))
    f32 = jnp.float32

    def nrm(shape, fan_in):
        return jax.random.normal(next(ks), shape, f32) * (fan_in ** -0.5)

    def gain(shape):
        return 1.0 + 0.02 * jax.random.normal(next(ks), shape, f32)

    x = jax.random.normal(next(ks), (BATCH, SEQ, D_MODEL), f32)
    p = jax.random.normal(next(ks), (DEPTH, BATCH, SEQ, PLE_DIM), f32)
    offs = jax.random.randint(next(ks), (BATCH, 1), 0, 1024, dtype=jnp.int32)
    positions = (jnp.arange(SEQ, dtype=jnp.int32)[None, :] + offs).astype(jnp.int32)
    return {
        "x": x,
        "p": p,
        "positions": positions,
        "attn_norm": gain((DEPTH, D_MODEL)),
        "w_in": nrm((DEPTH, D_MODEL, IN_WIDTH), D_MODEL),
        "cq_norm": gain((DEPTH, Q_RANK)),
        "ckv_norm": gain((DEPTH, KV_RANK)),
        "w_uq": nrm((DEPTH, Q_RANK, MLA_HEADS * (MLA_NOPE + MLA_ROPE)), Q_RANK),
        "w_ukv": nrm((DEPTH, KV_RANK, MLA_HEADS * (MLA_NOPE + MLA_V)), KV_RANK),
        "swa_sink": 0.5 * jax.random.normal(next(ks), (DEPTH, SWA_HEADS), f32),
        "t5_bias": 0.5 * jax.random.normal(next(ks), (NUM_BUCKETS, SWA_HEADS), f32),
        "mla_out_norm": gain((DEPTH, MLA_WIDTH)),
        "swa_out_norm": gain((DEPTH, SWA_WIDTH)),
        "w_o": nrm((DEPTH, MIX_WIDTH, D_MODEL), MIX_WIDTH),
        "ffn_norm": gain((DEPTH, D_MODEL)),
        "w_gate": nrm((DEPTH, D_MODEL, D_FF), D_MODEL),
        "w_up": nrm((DEPTH, D_MODEL, D_FF), D_MODEL),
        "conv_w": nrm((DEPTH, CONV_W, D_FF), CONV_W),
        "conv_b": 0.01 * jax.random.normal(next(ks), (DEPTH, D_FF), f32),
        "w_down": nrm((DEPTH, D_FF, D_MODEL), D_FF),
        "ple_gate_w": nrm((DEPTH, D_MODEL, D_MODEL), D_MODEL),
        "ple_gate_b": 0.01 * jax.random.normal(next(ks), (DEPTH, D_MODEL), f32),
        "ple_proj": nrm((DEPTH, PLE_DIM, D_MODEL), PLE_DIM),
        "final_norm": gain((D_MODEL,)),
    }


def reference(x, p, positions, attn_norm, w_in, cq_norm, ckv_norm, w_uq, w_ukv, swa_sink, t5_bias,
              mla_out_norm, swa_out_norm, w_o, ffn_norm, w_gate, w_up, conv_w, conv_b, w_down,
              ple_gate_w, ple_gate_b, ple_proj, final_norm):
    B, S = x.shape[:2]
    cos, sin = rope_tables(positions)
    for i in range(DEPTH):
        h = rmsnorm(x, attn_norm[i])
        z = h @ w_in[i]
        z_cq, z_ckv, z_kr, z_q, z_k, z_v = jnp.split(z, IN_OFFSETS, axis=-1)
        mla_o = mla_attention(z_cq, z_ckv, z_kr, cq_norm[i], ckv_norm[i], w_uq[i], w_ukv[i], cos, sin)
        swa_o = swa_attention(z_q.reshape(B, S, SWA_HEADS, HEAD_DIM),
                              z_k.reshape(B, S, SWA_KV_HEADS, HEAD_DIM),
                              z_v.reshape(B, S, SWA_KV_HEADS, HEAD_DIM),
                              positions, swa_sink[i], t5_bias)
        mixed = jnp.concatenate([rmsnorm(mla_o, mla_out_norm[i]), rmsnorm(swa_o, swa_out_norm[i])], axis=-1)
        x = x + mixed @ w_o[i]
        h2 = rmsnorm(x, ffn_norm[i])
        g = depthwise_conv3(h2 @ w_gate[i], conv_w[i], conv_b[i])
        x = x + (jax.nn.silu(g) * (h2 @ w_up[i])) @ w_down[i]
        x = x + jax.nn.sigmoid(x @ ple_gate_w[i] + ple_gate_b[i]) * (p[i] @ ple_proj[i])
    return rmsnorm(x, final_norm)
```

```cpp
#include <hip/hip_runtime.h>
#include <hip/hip_cooperative_groups.h>
#include <cstdio>
#include <cstdint>
namespace cg = cooperative_groups;

#ifndef MK_PHMASK
#define MK_PHMASK 0xFFFFFFFFu
#endif
#define EN(k) (((MK_PHMASK) >> (k)) & 1u)
#ifndef MK_DUP
#define MK_DUP -1
#endif
#ifndef MK_MULTI
#define MK_MULTI 0
#endif

constexpr int BATCH = 2, SEQ = 16384, T = BATCH * SEQ, DM = 2048, DEPTH = 2, PLE = 256;
constexpr int QRANK = 384, KVRANK = 256, ROPE = 64, NH = 8;
constexpr int INW = 2240, ZW = 2304;
constexpr int OFF_CQ = 0, OFF_CKV = 384, OFF_KR = 640, OFF_SQ = 704, OFF_SK = 1728, OFF_SV = 1984;
constexpr int QW = 1536, KVW = 2048, FF = 5504, GUW = 2 * FF;
constexpr float EPS = 1e-6f;
constexpr int NPH_LAYER = 12, NPHASE = DEPTH * NPH_LAYER + 1;

constexpr size_t MiB = 1u << 20;
constexpr size_t WS_RSQ = 0, WS_RSKV = 256 * 1024, WS_COS = 1 * MiB, WS_SIN = 5 * MiB;
constexpr size_t WS_BAR = 512 * 1024, WS_BAR_BYTES = 16384;
constexpr size_t WS_SSQ0 = 896 * MiB, WS_SSQ1 = 897 * MiB;
constexpr float SSQ_FX = 65536.f, SSQ_INV = 1.f / 65536.f;
constexpr size_t WS_KR = 9 * MiB;
constexpr size_t WS_PB = 13 * MiB;
constexpr size_t WS_W = 29 * MiB;
constexpr size_t W_IN = WS_W, W_UQ = W_IN + (size_t)ZW * DM * 2, W_UKV = W_UQ + (size_t)QW * QRANK * 2, W_O = W_UKV + (size_t)KVW * KVRANK * 2,
                 W_GU = W_O + (size_t)DM * DM * 2, W_D = W_GU + (size_t)GUW * DM * 2, W_PG = W_D + (size_t)DM * FF * 2, W_PP = W_PG + (size_t)DM * DM * 2,
                 W_END = W_PP + (size_t)DM * PLE * 2;
constexpr size_t WS_H = 126 * MiB;
constexpr size_t WS_BIG = 254 * MiB;
constexpr size_t WS_Z = WS_BIG, WS_Q = WS_Z + (size_t)T * ZW * 2, WS_KV = WS_Q + (size_t)T * QW * 2, WS_KV_END = WS_KV + (size_t)T * KVW * 2;
constexpr size_t WS_ACT = WS_BIG, WS_ACT_END = WS_ACT + (size_t)T * FF * 2;
constexpr size_t WS_SBG = 622 * MiB, WS_SBU = WS_SBG + (size_t)(T / 256) * 4 * FF * 2, WS_SB_END = WS_SBU + (size_t)(T / 256) * 2 * FF * 2;
constexpr size_t WS_PG = WS_BIG;
constexpr size_t WS_XB1 = 640 * MiB, WS_XB0 = 768 * MiB, WS_NEED = WS_SSQ1 + (size_t)T * 8;
static_assert(W_END <= WS_H && WS_H + (size_t)T * DM * 2 <= WS_BIG && WS_KV_END <= WS_SBG && WS_ACT_END <= WS_SBG && WS_SB_END <= WS_XB1 && WS_NEED <= (size_t)1024 * MiB, "ws map");

#define LAS __attribute__((address_space(3)))
#define GAS __attribute__((address_space(1)))
typedef unsigned short bf16_t;
typedef short bf16x8 __attribute__((ext_vector_type(8)));
typedef short s16x4 __attribute__((ext_vector_type(4)));
typedef float f32x4 __attribute__((ext_vector_type(4)));
typedef float f32x8 __attribute__((ext_vector_type(8)));
typedef float f32x16 __attribute__((ext_vector_type(16)));
typedef unsigned u32x4 __attribute__((ext_vector_type(4)));
typedef unsigned u32x2 __attribute__((ext_vector_type(2)));
typedef unsigned long long u64_t;

__device__ __forceinline__ unsigned cvt_pk_bf16(float lo, float hi) { unsigned r; asm volatile("v_cvt_pk_bf16_f32 %0, %1, %2" : "=v"(r) : "v"(lo), "v"(hi)); return r; }
__device__ __forceinline__ int tid_now(int wave_s) { int z; asm volatile("v_mov_b32 %0, 0" : "=v"(z)); return wave_s * 64 + (int)__builtin_amdgcn_mbcnt_hi(~0u, __builtin_amdgcn_mbcnt_lo(~0u, (unsigned)z)); }
__device__ __forceinline__ unsigned opaque_zero() { unsigned z; asm volatile("v_mov_b32 %0, 0" : "=v"(z)); return z; }
__device__ __forceinline__ float bf_lo(unsigned w) { return __uint_as_float(w << 16); }
__device__ __forceinline__ float bf_hi(unsigned w) { return __uint_as_float(w & 0xffff0000u); }
__device__ __forceinline__ float wave_sum(float v, int lane) {
#pragma unroll
    for (int o = 1; o < 64; o <<= 1) v += __int_as_float(__builtin_amdgcn_ds_bpermute((lane ^ o) << 2, __float_as_int(v)));
    return v;
}

namespace pg8 {
constexpr int BM = 256, BK = 64, HALF = 128, HTB = HALF * BK * 2, STAGE_BYTES = 8 * HTB, NXCD = 8, WGM = 4;
__host__ __device__ __forceinline__ int lds_byte(int r, int c) { const int st = (r >> 4) * 2 + (c >> 5), rr = r & 15, cc = c & 31, ob = rr * 64 + cc * 2; return st * 1024 + (ob ^ (((ob >> 9) & 1) << 5)); }
__host__ __device__ __forceinline__ void stage_rc(int b, int& R, int& C) { const int st = b / 1024, sb = b % 1024, swz = sb ^ (((sb >> 9) & 1) << 5); R = (st >> 1) * 16 + swz / 64; C = (st & 1) * 32 + (swz % 64) / 2; }
__host__ __device__ __forceinline__ int perm32(int rho) { const int n = rho >> 4, i = rho & 15; return 8 * (i >> 2) + 4 * n + (i & 3); }

struct Unit { int pm, pn; };
struct Gemm { const bf16_t* A; const bf16_t* Bt; int M, N, K, lda; };

struct StaticOrder {
    int nM, nN, nwg, G, c;
    __device__ void init(int M, int N, int G_, int c_) { nM = M / BM; nN = N / BM; nwg = nM * nN; G = G_; c = c_; }
    __device__ bool next(int i, Unit& u) const {
        const long L = (long)i * G + c; if (L >= nwg) return false;
        int wgid = (int)L; { const int q = nwg / NXCD, r = nwg % NXCD, xcd = wgid % NXCD, off = wgid / NXCD; wgid = (xcd < r ? xcd * (q + 1) : r * (q + 1) + (xcd - r) * q) + off; }
        const int nig = WGM * nN, gid = wgid / nig, fm = gid * WGM, gsz = (nM - fm) < WGM ? (nM - fm) : WGM;
        u.pm = fm + ((wgid % nig) % gsz); u.pn = (wgid % nig) / gsz; return true;
    }
};

struct EpiBf16 {
    bf16_t* O; int ldc; const float* rs; const u64_t* ssqp;
    __device__ __forceinline__ void operator()(const f32x4 (&acc)[2][2][4][2], const Unit& u, int wr, int wc, int fr, int fq) const {
        const int row0 = u.pm * BM + wr * 64 + fr, col0 = u.pn * BM + wc * 32 + 8 * fq;
#pragma unroll
        for (int ai = 0; ai < 2; ++ai)
#pragma unroll
            for (int m = 0; m < 4; ++m) { const int r = row0 + ai * HALF + m * 16; float s = rs ? *(const GAS float*)(rs + r) : 1.f; if (ssqp) s = rsqrtf((float)*(const GAS u64_t*)(ssqp + r) * (SSQ_INV / DM) + EPS); bf16_t* rowp = O + (size_t)r * ldc + col0;
#pragma unroll
                for (int bj = 0; bj < 2; ++bj) { const f32x4 v0 = acc[ai][bj][m][0] * s, v1 = acc[ai][bj][m][1] * s;
                    u32x4 w; w.x = cvt_pk_bf16(v0[0], v0[1]); w.y = cvt_pk_bf16(v0[2], v0[3]); w.z = cvt_pk_bf16(v1[0], v1[1]); w.w = cvt_pk_bf16(v1[2], v1[3]);
                    *(GAS u32x4*)(rowp + bj * HALF) = w; } }
    }
};
struct EpiQ {
    bf16_t* O; const float* rs; const float* cs; const float* sn;
    __device__ __forceinline__ void operator()(const f32x4 (&acc)[2][2][4][2], const Unit& u, int wr, int wc, int fr, int fq) const {
        const int row0 = u.pm * BM + wr * 64 + fr, col0 = u.pn * BM + wc * 32 + 8 * fq;
#pragma unroll
        for (int bj = 0; bj < 2; ++bj) {
            const int cb = u.pn * BM + bj * HALF + wc * 32, d = cb % 192; const bool rope = d >= 128; const int j0 = ((d - 128) >> 1) + 4 * fq;
#pragma unroll
            for (int ai = 0; ai < 2; ++ai)
#pragma unroll
                for (int m = 0; m < 4; ++m) { const int r = row0 + ai * HALF + m * 16; const float s = *(const GAS float*)(rs + r) * 0.10411754831265403f;
                    f32x4 v0 = acc[ai][bj][m][0] * s, v1 = acc[ai][bj][m][1] * s;
                    if (rope) { const f32x4 c4 = *(const GAS f32x4*)(cs + (size_t)r * 32 + j0), s4 = *(const GAS f32x4*)(sn + (size_t)r * 32 + j0);
                        f32x4 a, b; a[0] = v0[0] * c4[0] - v0[1] * s4[0]; a[1] = v0[0] * s4[0] + v0[1] * c4[0]; a[2] = v0[2] * c4[1] - v0[3] * s4[1]; a[3] = v0[2] * s4[1] + v0[3] * c4[1];
                        b[0] = v1[0] * c4[2] - v1[1] * s4[2]; b[1] = v1[0] * s4[2] + v1[1] * c4[2]; b[2] = v1[2] * c4[3] - v1[3] * s4[3]; b[3] = v1[2] * s4[3] + v1[3] * c4[3]; v0 = a; v1 = b; }
                    u32x4 w; w.x = cvt_pk_bf16(v0[0], v0[1]); w.y = cvt_pk_bf16(v0[2], v0[3]); w.z = cvt_pk_bf16(v1[0], v1[1]); w.w = cvt_pk_bf16(v1[2], v1[3]);
                    *(GAS u32x4*)(O + (size_t)r * QW + col0 + bj * HALF) = w; }
        }
    }
};
__device__ __forceinline__ float dpp_f(float oldv, float src, int ctrl_sel) {
    const int o = __float_as_int(oldv), v = __float_as_int(src); int r;
    if (ctrl_sel == 0) r = __builtin_amdgcn_update_dpp(o, v, 0x111, 0xf, 0xf, false);
    else if (ctrl_sel == 1) r = __builtin_amdgcn_update_dpp(o, v, 0x101, 0xf, 0xf, false);
    else if (ctrl_sel == 2) r = __builtin_amdgcn_update_dpp(o, v, 0x121, 0xf, 0xf, false);
    else r = __builtin_amdgcn_update_dpp(o, v, 0x12F, 0xf, 0xf, false);
    return __int_as_float(r);
}
struct EpiGU {
    bf16_t* ACT; bf16_t* SBG; bf16_t* SBU; const float* cw; const float* cb; LAS float* X; const u64_t* ssq;
    __device__ __forceinline__ void operator()(const f32x4 (&acc)[2][2][4][2], const Unit& u, int wr, int wc, int fr_, int fq_) const {
        int fr = fr_, fq = fq_; asm volatile("" : "+v"(fr), "+v"(fq));
        const int colf = u.pn * HALF + wc * 32 + 8 * fq;
        float rs[2][4];
#pragma unroll
        for (int ai = 0; ai < 2; ++ai)
#pragma unroll
            for (int m = 0; m < 4; ++m) rs[ai][m] = rsqrtf((float)*(const GAS u64_t*)(ssq + (size_t)u.pm * BM + ai * HALF + wr * 64 + m * 16 + fr) * (SSQ_INV / DM) + EPS);
#pragma unroll
        for (int ai = 0; ai < 2; ++ai) { const int bidx = 2 * ai + wr; LAS float* xb = X + ((bidx * 4 + wc) * 2) * 32 + fq * 8;
            if (fr == 0) { *(LAS f32x4*)(xb) = acc[ai][0][0][0] * rs[ai][0]; *(LAS f32x4*)(xb + 4) = acc[ai][0][0][1] * rs[ai][0]; }
            if (fr == 15) { *(LAS f32x4*)(xb + 32) = acc[ai][0][3][0] * rs[ai][3]; *(LAS f32x4*)(xb + 36) = acc[ai][0][3][1] * rs[ai][3]; } }
        asm volatile("s_waitcnt lgkmcnt(0)\n\ts_barrier" ::: "memory");
#pragma unroll
        for (int n = 0; n < 2; ++n) {
            const f32x4 w0 = *(const GAS f32x4*)(cw + colf + 4 * n), w1 = *(const GAS f32x4*)(cw + FF + colf + 4 * n), w2 = *(const GAS f32x4*)(cw + 2 * FF + colf + 4 * n), bb = *(const GAS f32x4*)(cb + colf + 4 * n);
#pragma unroll
            for (int ai = 0; ai < 2; ++ai) { const int bidx = 2 * ai + wr;
                f32x4 ep = (f32x4){0.f, 0.f, 0.f, 0.f}, en = (f32x4){0.f, 0.f, 0.f, 0.f};
                if (bidx > 0) ep = *(const LAS f32x4*)(X + (((bidx - 1) * 4 + wc) * 2 + 1) * 32 + fq * 8 + 4 * n);
                if (bidx < 3) en = *(const LAS f32x4*)(X + (((bidx + 1) * 4 + wc) * 2) * 32 + fq * 8 + 4 * n);
                f32x4 gs[4];
#pragma unroll
                for (int m = 0; m < 4; ++m) gs[m] = acc[ai][0][m][n] * rs[ai][m];
#pragma unroll
                for (int m = 0; m < 4; ++m) { const int rt = ai * HALF + wr * 64 + m * 16 + fr; const size_t r = (size_t)u.pm * BM + rt; float ov[4];
#pragma unroll
                    for (int i = 0; i < 4; ++i) { const float g = gs[m][i];
                        const float oldp = (m > 0) ? dpp_f(0.f, gs[m > 0 ? m - 1 : 0][i], 2) : ep[i];
                        const float gp = dpp_f(oldp, g, 0);
                        const float oldn = (m < 3) ? dpp_f(0.f, gs[m < 3 ? m + 1 : 3][i], 3) : en[i];
                        const float gn = dpp_f(oldn, g, 1);
                        const float c = w0[i] * gp + w1[i] * g + w2[i] * gn + bb[i];
                        ov[i] = c * __builtin_amdgcn_rcpf(1.f + __expf(-c)) * (acc[ai][1][m][n][i] * rs[ai][m]); }
                    u32x2 wv; wv.x = cvt_pk_bf16(ov[0], ov[1]); wv.y = cvt_pk_bf16(ov[2], ov[3]);
                    *(GAS u32x2*)(ACT + r * FF + colf + 4 * n) = wv;
                    if (rt < 2 || rt >= 254) {
                        const int si = rt < 2 ? rt : rt - 252; const f32x4 g0 = gs[m]; u32x2 gw; gw.x = cvt_pk_bf16(g0[0], g0[1]); gw.y = cvt_pk_bf16(g0[2], g0[3]);
                        *(GAS u32x2*)(SBG + ((size_t)u.pm * 4 + si) * FF + colf + 4 * n) = gw;
                        if (rt == 0 || rt == 255) { const f32x4 u0 = acc[ai][1][m][n] * rs[ai][m]; u32x2 uw; uw.x = cvt_pk_bf16(u0[0], u0[1]); uw.y = cvt_pk_bf16(u0[2], u0[3]);
                            *(GAS u32x2*)(SBU + ((size_t)u.pm * 2 + (rt ? 1 : 0)) * FF + colf + 4 * n) = uw; } } }
            }
        }
    }
};
__device__ __forceinline__ void ssq_commit(u64_t* ssq, float (&q)[2][4], int row0, int fr, int fq) {
    const int lane = fq * 16 + fr;
#pragma unroll
    for (int ai = 0; ai < 2; ++ai)
#pragma unroll
        for (int m = 0; m < 4; ++m) { float v = q[ai][m];
            v += __int_as_float(__builtin_amdgcn_ds_bpermute((lane ^ 16) << 2, __float_as_int(v)));
            v += __int_as_float(__builtin_amdgcn_ds_bpermute((lane ^ 32) << 2, __float_as_int(v)));
            if (fq == 0) __hip_atomic_fetch_add(ssq + row0 + ai * HALF + m * 16, (u64_t)(v * SSQ_FX + 0.5f), __ATOMIC_RELAXED, __HIP_MEMORY_SCOPE_AGENT); }
}
struct EpiRes {
    const float* base; const bf16_t* baseb; float* out; bf16_t* xb; u64_t* ssq;
    __device__ __forceinline__ void operator()(const f32x4 (&acc)[2][2][4][2], const Unit& u, int wr, int wc, int fr, int fq) const {
        const int row0 = u.pm * BM + wr * 64 + fr, col0 = u.pn * BM + wc * 32 + 8 * fq;
        float q[2][4];
#pragma unroll
        for (int ai = 0; ai < 2; ++ai)
#pragma unroll
            for (int m = 0; m < 4; ++m) { const size_t off = (size_t)(row0 + ai * HALF + m * 16) * DM + col0; q[ai][m] = 0.f;
#pragma unroll
                for (int bj = 0; bj < 2; ++bj) { f32x4 b0, b1;
                    if (baseb) { const u32x4 bw = *(const GAS u32x4*)(baseb + off + bj * HALF); b0 = (f32x4){bf_lo(bw.x), bf_hi(bw.x), bf_lo(bw.y), bf_hi(bw.y)}; b1 = (f32x4){bf_lo(bw.z), bf_hi(bw.z), bf_lo(bw.w), bf_hi(bw.w)}; }
                    else { b0 = *(const GAS f32x4*)(base + off + bj * HALF); b1 = *(const GAS f32x4*)(base + off + bj * HALF + 4); }
                    const f32x4 o0 = b0 + acc[ai][bj][m][0], o1 = b1 + acc[ai][bj][m][1];
                    if (out) { *(GAS f32x4*)(out + off + bj * HALF) = o0; *(GAS f32x4*)(out + off + bj * HALF + 4) = o1; }
                    q[ai][m] += (o0[0] * o0[0] + o0[1] * o0[1]) + (o0[2] * o0[2] + o0[3] * o0[3]) + (o1[0] * o1[0] + o1[1] * o1[1]) + (o1[2] * o1[2] + o1[3] * o1[3]);
                    if (xb) { u32x4 w; w.x = cvt_pk_bf16(o0[0], o0[1]); w.y = cvt_pk_bf16(o0[2], o0[3]); w.z = cvt_pk_bf16(o1[0], o1[1]); w.w = cvt_pk_bf16(o1[2], o1[3]); *(GAS u32x4*)(xb + off + bj * HALF) = w; } } }
        if (ssq) ssq_commit(ssq, q, row0, fr, fq);
    }
};
struct EpiPle {
    const bf16_t* baseb; float* out; const float* bias; const bf16_t* pp; bf16_t* xb; u64_t* ssq;
    __device__ __forceinline__ void operator()(const f32x4 (&acc)[2][2][4][2], const Unit& u, int wr, int wc, int fr, int fq) const {
        const int row0 = u.pm * BM + wr * 64 + fr, col0 = u.pn * BM + wc * 32 + 8 * fq;
        f32x4 bv[2][2]; float q[2][4];
#pragma unroll
        for (int bj = 0; bj < 2; ++bj) { bv[bj][0] = *(const GAS f32x4*)(bias + col0 + bj * HALF); bv[bj][1] = *(const GAS f32x4*)(bias + col0 + bj * HALF + 4); }
#pragma unroll
        for (int ai = 0; ai < 2; ++ai)
#pragma unroll
            for (int m = 0; m < 4; ++m) { const size_t off = (size_t)(row0 + ai * HALF + m * 16) * DM + col0; q[ai][m] = 0.f;
#pragma unroll
                for (int bj = 0; bj < 2; ++bj) { const u32x4 bw = *(const GAS u32x4*)(baseb + off + bj * HALF);
                    const f32x4 b0 = {bf_lo(bw.x), bf_hi(bw.x), bf_lo(bw.y), bf_hi(bw.y)}, b1 = {bf_lo(bw.z), bf_hi(bw.z), bf_lo(bw.w), bf_hi(bw.w)};
                    const u32x4 pw = *(const GAS u32x4*)(pp + off + bj * HALF);
                    const f32x4 p0 = {bf_lo(pw.x), bf_hi(pw.x), bf_lo(pw.y), bf_hi(pw.y)}, p1 = {bf_lo(pw.z), bf_hi(pw.z), bf_lo(pw.w), bf_hi(pw.w)};
                    const f32x4 z0 = acc[ai][bj][m][0] + bv[bj][0], z1 = acc[ai][bj][m][1] + bv[bj][1]; f32x4 g0, g1;
#pragma unroll
                    for (int i = 0; i < 4; ++i) { g0[i] = __builtin_amdgcn_rcpf(1.f + __expf(-z0[i])); g1[i] = __builtin_amdgcn_rcpf(1.f + __expf(-z1[i])); }
                    const f32x4 o0 = b0 + g0 * p0, o1 = b1 + g1 * p1;
                    if (out) { *(GAS f32x4*)(out + off + bj * HALF) = o0; *(GAS f32x4*)(out + off + bj * HALF + 4) = o1; }
                    if (xb) { q[ai][m] += (o0[0] * o0[0] + o0[1] * o0[1]) + (o0[2] * o0[2] + o0[3] * o0[3]) + (o1[0] * o1[0] + o1[1] * o1[1]) + (o1[2] * o1[2] + o1[3] * o1[3]);
                        u32x4 w; w.x = cvt_pk_bf16(o0[0], o0[1]); w.y = cvt_pk_bf16(o0[2], o0[3]); w.z = cvt_pk_bf16(o1[0], o1[1]); w.w = cvt_pk_bf16(o1[2], o1[3]); *(GAS u32x4*)(xb + off + bj * HALF) = w; } } }
        if (xb) ssq_commit(ssq, q, row0, fr, fq);
    }
};

template <class Epi, bool ALIGN_EPI>
__device__ __forceinline__ void gemm_phase(LAS unsigned char* lds, const Gemm g, const StaticOrder& S, const Epi& E, const int wave_s) {
    int tid_ = tid_now(wave_s); asm volatile("" : "+v"(tid_));
    const int tid = tid_, wid = __builtin_amdgcn_readfirstlane(tid >> 6), lane = tid & 63, wr = wid >> 2, wc = wid & 3, fr = lane & 15, fq = lane >> 4;
    int K_ = g.K, lda_ = g.lda; asm volatile("" : "+s"(K_), "+s"(lda_));
    const int K = K_, nt = K / BK, lda = lda_;
    unsigned voffA[2], voffB[2];
#pragma unroll
    for (int i = 0; i < 2; ++i) { int R, C; stage_rc(tid * 16 + i * 8192, R, C); const int Rb = (R & ~31) + perm32(R & 31);
        voffA[i] = (unsigned)(R * lda + C) * 2u; voffB[i] = (unsigned)(Rb * K + C) * 2u; }
    const size_t kstep = (size_t)(BK * 2);
    const size_t hstepA = (size_t)HALF * lda * 2, hstepB = (size_t)HALF * K * 2;
    const size_t tstepA = 2 * hstepA, tstepB = 2 * hstepB;
    const unsigned ldsw = (unsigned)wid * 1024u;
    const int aoff = lds_byte(wr * 64 + fr, fq * 8), boff = lds_byte(wc * 32 + fr, fq * 8);
#define PG8_SA(b, h) (((b) * 2 + (h)) * HTB)
#define PG8_SB(b, h) ((4 + (b) * 2 + (h)) * HTB)
#define PG8_STAGE(bufoff, gbase, voff) do { _Pragma("unroll") for (int _i = 0; _i < 2; ++_i) \
        __builtin_amdgcn_global_load_lds((const unsigned*)((const char*)(gbase) + (voff)[_i]), (LAS unsigned*)(lds + (bufoff) + ldsw + _i * 8192), 16, 0, 0); } while (0)
#define PG8_LDA(dst, b, h) do { _Pragma("unroll") for (int m = 0; m < 4; ++m) _Pragma("unroll") for (int k = 0; k < 2; ++k) dst[m][k] = *(const LAS bf16x8*)(lds + PG8_SA(b, h) + aoff + m * 2048 + k * 1024); } while (0)
#define PG8_LDB(dst, b, h) do { _Pragma("unroll") for (int n = 0; n < 2; ++n) _Pragma("unroll") for (int k = 0; k < 2; ++k) dst[n][k] = *(const LAS bf16x8*)(lds + PG8_SB(b, h) + boff + n * 2048 + k * 1024); } while (0)
#define PG8_MMA(ai, bj, At, Bt) do { __builtin_amdgcn_s_setprio(1); _Pragma("unroll") for (int m = 0; m < 4; ++m) _Pragma("unroll") for (int n = 0; n < 2; ++n) _Pragma("unroll") for (int k = 0; k < 2; ++k) \
        acc[ai][bj][m][n] = __builtin_amdgcn_mfma_f32_16x16x32_bf16(Bt[n][k], At[m][k], acc[ai][bj][m][n], 0, 0, 0); __builtin_amdgcn_s_setprio(0); } while (0)
#define PG8_WAIT_V(n) asm volatile("s_waitcnt vmcnt(" #n ")" ::: "memory")
#define PG8_WAIT_L(n) asm volatile("s_waitcnt lgkmcnt(" #n ")" ::: "memory")
#define PG8_BAR __builtin_amdgcn_s_barrier()
#define PG8_SCHED __builtin_amdgcn_sched_barrier(0)
    Unit cur, nxt; int ui = 0;
    if (!S.next(0, cur)) return;
    f32x4 acc[2][2][4][2];
    float zz0; asm volatile("v_mov_b32 %0, 0" : "=v"(zz0));
#pragma unroll
    for (int a = 0; a < 2; ++a)
#pragma unroll
        for (int b = 0; b < 2; ++b)
#pragma unroll
            for (int m = 0; m < 4; ++m)
#pragma unroll
                for (int n = 0; n < 2; ++n) acc[a][b][m][n] = (f32x4){zz0, zz0, zz0, zz0};
    bf16x8 At[4][2], B0[2][2], B1[2][2];
    const char* cA = (const char*)g.A + (size_t)cur.pm * tstepA; const char* cB = (const char*)g.Bt + (size_t)cur.pn * tstepB;
    PG8_STAGE(PG8_SB(0, 0), cB, voffB); PG8_STAGE(PG8_SB(0, 1), cB + hstepB, voffB); PG8_STAGE(PG8_SA(0, 0), cA, voffA); PG8_STAGE(PG8_SA(0, 1), cA + hstepA, voffA);
    if (wr == 1) PG8_BAR;
    PG8_WAIT_V(2); PG8_BAR;
    PG8_STAGE(PG8_SB(1, 0), cB + kstep, voffB); PG8_STAGE(PG8_SA(1, 0), cA + kstep, voffA); PG8_STAGE(PG8_SB(1, 1), cB + hstepB + kstep, voffB);
    PG8_WAIT_V(6); PG8_BAR;
    for (;;) {
        const bool has_next = S.next(ui + 1, nxt);
        const char* nA = has_next ? (const char*)g.A + (size_t)nxt.pm * tstepA : cA; const char* nB = has_next ? (const char*)g.Bt + (size_t)nxt.pn * tstepB : cB;
        for (int t = 0; t < nt; t += 2) {
            const bool last = (t == nt - 2);
            const char* a1 = cA + (size_t)(t + 1) * kstep;
            const char* a2 = last ? nA : cA + (size_t)(t + 2) * kstep; const char* b2 = last ? nB : cB + (size_t)(t + 2) * kstep;
            const char* a3 = a2 + kstep; const char* b3 = b2 + kstep;
            PG8_LDB(B0, 0, 0); PG8_LDB(B1, 0, 1); PG8_SCHED; PG8_LDA(At, 0, 0); PG8_STAGE(PG8_SA(1, 1), a1 + hstepA, voffA);
            PG8_WAIT_V(8); PG8_WAIT_L(0); PG8_BAR; PG8_MMA(0, 0, At, B0); PG8_MMA(0, 1, At, B1); PG8_BAR; PG8_SCHED;
            PG8_LDA(At, 0, 1); PG8_STAGE(PG8_SB(0, 0), b2, voffB); PG8_STAGE(PG8_SB(0, 1), b2 + hstepB, voffB); PG8_STAGE(PG8_SA(0, 0), a2, voffA);
            PG8_WAIT_V(8); PG8_WAIT_L(0); PG8_BAR; PG8_MMA(1, 0, At, B0); PG8_MMA(1, 1, At, B1); PG8_BAR; PG8_SCHED;
            PG8_LDB(B0, 1, 0); PG8_LDB(B1, 1, 1); PG8_SCHED; PG8_LDA(At, 1, 0); PG8_STAGE(PG8_SA(0, 1), a2 + hstepA, voffA);
            PG8_WAIT_V(8); PG8_WAIT_L(0); PG8_BAR; PG8_MMA(0, 0, At, B0); PG8_MMA(0, 1, At, B1); PG8_BAR; PG8_SCHED;
            PG8_LDA(At, 1, 1); PG8_STAGE(PG8_SB(1, 0), b3, voffB); PG8_STAGE(PG8_SB(1, 1), b3 + hstepB, voffB); PG8_STAGE(PG8_SA(1, 0), a3, voffA);
            PG8_WAIT_V(8); PG8_WAIT_L(0); PG8_BAR; PG8_MMA(1, 0, At, B0); PG8_MMA(1, 1, At, B1); PG8_BAR; PG8_SCHED;
        }
        if constexpr (ALIGN_EPI) { if (wr == 0) PG8_BAR; }
        E(acc, cur, wr, wc, fr, fq);
        if (!has_next) break;
        float zz1; asm volatile("v_mov_b32 %0, 0" : "=v"(zz1));
#pragma unroll
        for (int a = 0; a < 2; ++a)
#pragma unroll
            for (int b = 0; b < 2; ++b)
#pragma unroll
                for (int m = 0; m < 4; ++m)
#pragma unroll
                    for (int n = 0; n < 2; ++n) acc[a][b][m][n] = (f32x4){zz1, zz1, zz1, zz1};
        cur = nxt; cA = nA; cB = nB; ++ui;
        if constexpr (ALIGN_EPI) { if (wr == 1) PG8_BAR; }
    }
    PG8_WAIT_V(0);
    if constexpr (!ALIGN_EPI) { if (wr == 0) PG8_BAR; }
    PG8_BAR;
#undef PG8_SA
#undef PG8_SB
#undef PG8_STAGE
#undef PG8_LDA
#undef PG8_LDB
#undef PG8_MMA
#undef PG8_WAIT_V
#undef PG8_WAIT_L
#undef PG8_BAR
#undef PG8_SCHED
}
}

namespace att {
constexpr int QBLK = 32, KVBLK = 64;
constexpr int SHM_V = 16384, SHM_K = 16384, SHM_KR = 8192;
constexpr int OFF_K = 0, OFF_KRL = OFF_K + 3 * SHM_K, OFF_V = OFF_KRL + 3 * SHM_KR, OFF_WSF = OFF_V + 3 * SHM_V, OFF_BT = OFF_WSF + 8 * 64 * 4, LDS_END = OFF_BT + 768 * 4;
constexpr float THR = 8.f, LOG2E = 1.4426950408889634f;
constexpr float SC_MLA = 0.07216878364870322f  , SC_SWA = 0.08838834764831845f  ;
#define KSWZ(row, colB) ((row) * 256 + ((colB) ^ (((row) & 7) << 4)))
#define KRSWZ(row, colB) ((row) * 128 + ((colB) ^ (((row) & 7) << 4)))
#define SBAR() __builtin_amdgcn_sched_barrier(0)
__device__ __forceinline__ int crow(int r, int hi) { return (r & 3) + 8 * (r >> 2) + 4 * hi; }

template <bool MLA>
__device__ __forceinline__ void partialSM(f32x16& p0, f32x16& p1, float& m_reg, float& mn, float& alpha) {
    constexpr float SCL = MLA ? SC_MLA : 1.f, C = SCL * LOG2E;
    float pmax = p0[0];
#pragma unroll
    for (int r = 1; r < 16; ++r) pmax = fmaxf(pmax, p0[r]);
#pragma unroll
    for (int r = 0; r < 16; ++r) pmax = fmaxf(pmax, p1[r]);
    { auto rr = __builtin_amdgcn_permlane32_swap(__float_as_uint(pmax), __float_as_uint(pmax), false, false);
      pmax = fmaxf(__uint_as_float(rr[0]), __uint_as_float(rr[1])); }
    if (__builtin_expect(__all(pmax - m_reg <= THR / SCL), 1)) { mn = m_reg; alpha = 1.f; }
    else { mn = fmaxf(m_reg, pmax); alpha = __builtin_amdgcn_exp2f((m_reg - mn) * C); m_reg = mn; }
    const float mnC = -mn * C;
#pragma unroll
    for (int r = 0; r < 16; ++r) p0[r] = fmaf(p0[r], C, mnC);
#pragma unroll
    for (int r = 0; r < 16; ++r) p1[r] = fmaf(p1[r], C, mnC);
#pragma unroll
    for (int r = 0; r < 16; ++r) p0[r] = __builtin_amdgcn_exp2f(p0[r]);
}
template <bool FIRST>
__device__ __forceinline__ void partialSM_mla(f32x16& p0, f32x16& p1, float& m_reg, f32x16& negm, float& alpha) {
    constexpr float THRL = THR * LOG2E;
    float pmax = p0[0];
#pragma unroll
    for (int r = 1; r < 16; ++r) pmax = fmaxf(pmax, p0[r]);
#pragma unroll
    for (int r = 0; r < 16; ++r) pmax = fmaxf(pmax, p1[r]);
    { auto rr = __builtin_amdgcn_permlane32_swap(__float_as_uint(pmax), __float_as_uint(pmax), false, false);
      pmax = fmaxf(__uint_as_float(rr[0]), __uint_as_float(rr[1])); }
    if (!FIRST && __builtin_expect(__all(pmax <= THRL), 1)) { alpha = 1.f; }
    else { const float dl = FIRST ? pmax : fmaxf(pmax, 0.f); m_reg += dl; alpha = FIRST ? 1.f : __builtin_amdgcn_exp2f(-dl);
#pragma unroll
        for (int r = 0; r < 16; ++r) { p0[r] -= dl; p1[r] -= dl; }
#pragma unroll
        for (int r = 0; r < 16; ++r) negm[r] = -m_reg;
        asm volatile("" : "+v"(negm)); }
#pragma unroll
    for (int r = 0; r < 16; ++r) p0[r] = __builtin_amdgcn_exp2f(p0[r]);
}
__device__ __forceinline__ void finishSM(f32x16& p0, f32x16& p1, float alpha, float& l_reg, bf16x8& pa0, bf16x8& pa1, bf16x8& pa2, bf16x8& pa3) {
#pragma unroll
    for (int r = 0; r < 16; ++r) p1[r] = __builtin_amdgcn_exp2f(p1[r]);
    float ps = 0;
#pragma unroll
    for (int r = 0; r < 16; ++r) ps += p0[r];
#pragma unroll
    for (int r = 0; r < 16; ++r) ps += p1[r];
    { auto rr = __builtin_amdgcn_permlane32_swap(__float_as_uint(ps), __float_as_uint(ps), false, false);
      ps = __uint_as_float(rr[0]) + __uint_as_float(rr[1]); }
    l_reg = l_reg * alpha + ps;
#define PK4(P, BASE, OUT) do { unsigned a0 = cvt_pk_bf16(P[BASE + 0], P[BASE + 1]), a1 = cvt_pk_bf16(P[BASE + 2], P[BASE + 3]);   \
    unsigned b0 = cvt_pk_bf16(P[BASE + 4], P[BASE + 5]), b1 = cvt_pk_bf16(P[BASE + 6], P[BASE + 7]);                              \
    auto r0 = __builtin_amdgcn_permlane32_swap(a0, b0, false, false); auto r1 = __builtin_amdgcn_permlane32_swap(a1, b1, false, false); \
    u32x4 w = {r0[0], r1[0], r0[1], r1[1]}; OUT = *reinterpret_cast<bf16x8*>(&w); } while (0)
    PK4(p0, 0, pa0); PK4(p0, 8, pa1); PK4(p1, 0, pa2); PK4(p1, 8, pa3);
#undef PK4
}
template <bool MLA>
__device__ __forceinline__ void qkt(f32x16& p0, f32x16& p1, const char* Ks, const char* Krs, const bf16x8* qr, int r32, int hi, const f32x16& cinit) {
    p0 = cinit; p1 = cinit;
#pragma unroll
    for (int d0 = 0; d0 < 8; ++d0) { const int cb = (d0 * 16 + hi * 8) * 2;
        const bf16x8 b0 = *reinterpret_cast<const bf16x8*>(Ks + KSWZ(r32, cb));
        const bf16x8 b1 = *reinterpret_cast<const bf16x8*>(Ks + KSWZ(32 + r32, cb));
        p0 = __builtin_amdgcn_mfma_f32_32x32x16_bf16(b0, qr[d0], p0, 0, 0, 0);
        p1 = __builtin_amdgcn_mfma_f32_32x32x16_bf16(b1, qr[d0], p1, 0, 0, 0); }
    if constexpr (MLA) {
#pragma unroll
        for (int d0 = 0; d0 < 4; ++d0) { const int cb = (d0 * 16 + hi * 8) * 2;
            const bf16x8 b0 = *reinterpret_cast<const bf16x8*>(Krs + KRSWZ(r32, cb));
            const bf16x8 b1 = *reinterpret_cast<const bf16x8*>(Krs + KRSWZ(32 + r32, cb));
            p0 = __builtin_amdgcn_mfma_f32_32x32x16_bf16(b0, qr[8 + d0], p0, 0, 0, 0);
            p1 = __builtin_amdgcn_mfma_f32_32x32x16_bf16(b1, qr[8 + d0], p1, 0, 0, 0); }
    }
}
#define PK4(P, BASE, OUT) do { unsigned a0 = cvt_pk_bf16(P[BASE + 0], P[BASE + 1]), a1 = cvt_pk_bf16(P[BASE + 2], P[BASE + 3]);   \
    unsigned b0_ = cvt_pk_bf16(P[BASE + 4], P[BASE + 5]), b1_ = cvt_pk_bf16(P[BASE + 6], P[BASE + 7]);                              \
    auto r0 = __builtin_amdgcn_permlane32_swap(a0, b0_, false, false); auto r1 = __builtin_amdgcn_permlane32_swap(a1, b1_, false, false); \
    u32x4 w = {r0[0], r1[0], r0[1], r1[1]}; OUT = *reinterpret_cast<bf16x8*>(&w); } while (0)
#define LFIN() do { auto rr = __builtin_amdgcn_permlane32_swap(__float_as_uint(ps), __float_as_uint(ps), false, false); \
    ps = __uint_as_float(rr[0]) + __uint_as_float(rr[1]); l_reg = l_reg * alpha + ps; } while (0)
__device__ __forceinline__ void pack_p0(const f32x16& p0, bf16x8& pa0, bf16x8& pa1, float& ps0) {
    float a = 0.f;
#pragma unroll
    for (int r = 0; r < 16; ++r) a += p0[r];
    ps0 = a; PK4(p0, 0, pa0); PK4(p0, 8, pa1);
}
__device__ __forceinline__ void fin_p1(f32x16& p1, float alpha, float& l_reg, float ps0, bf16x8& pa2, bf16x8& pa3) {
    float ps = ps0;
#pragma unroll
    for (int r = 0; r < 16; ++r) { p1[r] = __builtin_amdgcn_exp2f(p1[r]); ps += p1[r]; }
    LFIN(); PK4(p1, 0, pa2); PK4(p1, 8, pa3);
}
template <bool MLA>
__device__ __forceinline__ void qkt_fin(f32x16& n0, f32x16& n1, const char* Ks, const char* Krs, const bf16x8* qr, int r32, int hi, const f32x16& cinit,
                                        f32x16& p1, float alpha, float& l_reg, float ps0, bf16x8& pa2, bf16x8& pa3) {
    constexpr int NSTEP = MLA ? 12 : 8;
    float ps = ps0;
#pragma unroll
    for (int s_ = 0; s_ < NSTEP; ++s_) {
        const bool rope = s_ >= 8; const int d0 = rope ? s_ - 8 : s_; const int cb = (d0 * 16 + hi * 8) * 2;
        const bf16x8 b0 = rope ? *reinterpret_cast<const bf16x8*>(Krs + KRSWZ(r32, cb)) : *reinterpret_cast<const bf16x8*>(Ks + KSWZ(r32, cb));
        const bf16x8 b1 = rope ? *reinterpret_cast<const bf16x8*>(Krs + KRSWZ(32 + r32, cb)) : *reinterpret_cast<const bf16x8*>(Ks + KSWZ(32 + r32, cb));
        if (s_ == 0) { n0 = __builtin_amdgcn_mfma_f32_32x32x16_bf16(b0, qr[0], cinit, 0, 0, 0); n1 = __builtin_amdgcn_mfma_f32_32x32x16_bf16(b1, qr[0], cinit, 0, 0, 0); }
        else { n0 = __builtin_amdgcn_mfma_f32_32x32x16_bf16(b0, qr[s_], n0, 0, 0, 0); n1 = __builtin_amdgcn_mfma_f32_32x32x16_bf16(b1, qr[s_], n1, 0, 0, 0); }
        if (s_ < 8) { p1[2 * s_] = __builtin_amdgcn_exp2f(p1[2 * s_]); p1[2 * s_ + 1] = __builtin_amdgcn_exp2f(p1[2 * s_ + 1]); ps += p1[2 * s_] + p1[2 * s_ + 1]; }
        if (s_ == 4) PK4(p1, 0, pa2);
        if (MLA && s_ == 8) { LFIN(); PK4(p1, 8, pa3); }
        SBAR();
    }
    if (!MLA) { LFIN(); PK4(p1, 8, pa3); }
}
#undef PK4
#undef LFIN
__device__ __forceinline__ int v_st(int k, int c) { const int kk = (k & ~0xC) | ((k & 4) << 1) | ((k & 8) >> 1); return ((kk >> 3) * 4 + (c >> 5)) * 512 + ((kk & 7) * 32 + (c & 31)) * 2; }
__device__ __forceinline__ int v_rd_base(int lane) { return ((lane & 3) << 3) | (((lane >> 2) & 3) << 6) | (((lane >> 4) & 1) << 5) | (((lane >> 5) & 1) << 8); }
constexpr int v_rd_off(int d0, int ks, int half) { return d0 * 512 + ks * 4096 + half * 2048; }
template <int OFF> __device__ __forceinline__ s16x4 tr_read(int vb) {
    s16x4 r; asm volatile("ds_read_b64_tr_b16 %0, %1 offset:%2" : "=&v"(r) : "v"(vb), "i"(OFF) : "memory"); return r;
}
template <int KS> __device__ __forceinline__ void pv_ks(f32x16* o, int vb, bf16x8 pa) {
    const s16x4 l0 = tr_read<v_rd_off(0, KS, 0)>(vb), h0 = tr_read<v_rd_off(0, KS, 1)>(vb), l1 = tr_read<v_rd_off(1, KS, 0)>(vb), h1 = tr_read<v_rd_off(1, KS, 1)>(vb);
    const s16x4 l2 = tr_read<v_rd_off(2, KS, 0)>(vb), h2 = tr_read<v_rd_off(2, KS, 1)>(vb), l3 = tr_read<v_rd_off(3, KS, 0)>(vb), h3 = tr_read<v_rd_off(3, KS, 1)>(vb);
    asm volatile("s_waitcnt lgkmcnt(0)" ::: "memory"); SBAR();
#define PK(L, H) (bf16x8){L[0], L[1], L[2], L[3], H[0], H[1], H[2], H[3]}
    o[0] = __builtin_amdgcn_mfma_f32_32x32x16_bf16(pa, PK(l0, h0), o[0], 0, 0, 0);
    o[1] = __builtin_amdgcn_mfma_f32_32x32x16_bf16(pa, PK(l1, h1), o[1], 0, 0, 0);
    o[2] = __builtin_amdgcn_mfma_f32_32x32x16_bf16(pa, PK(l2, h2), o[2], 0, 0, 0);
    o[3] = __builtin_amdgcn_mfma_f32_32x32x16_bf16(pa, PK(l3, h3), o[3], 0, 0, 0);
#undef PK
}
__device__ __forceinline__ void pv_d0(f32x16* o, int vb, bf16x8 pa0, bf16x8 pa1, bf16x8 pa2, bf16x8 pa3) {
    pv_ks<0>(o, vb, pa0); pv_ks<1>(o, vb, pa1); pv_ks<2>(o, vb, pa2); pv_ks<3>(o, vb, pa3);
}
__device__ __forceinline__ void swa_fix(f32x16& p0, f32x16& p1, const float* bt, int relb, int hi) {
    const float* bp = bt + (relb + 384 + 4 * hi);
#pragma unroll
    for (int r = 0; r < 16; ++r) { const int c = (r & 3) + 8 * (r >> 2); p0[r] = fmaf(p0[r], SC_SWA, bp[c]); p1[r] = fmaf(p1[r], SC_SWA, bp[c + 32]); }
}

template <bool MLA, int ldq, int ldk, int ldo>
__device__ __forceinline__ void attn_unit(const bf16_t* Qb, const bf16_t* Kh, const bf16_t* Vh, const bf16_t* Krh,
                                          bf16_t* Ob, const int NT, char* lds, const int rel0, const float sink, const int wave_s) {
    constexpr int NQ = MLA ? 12 : 8;
    int tid_ = tid_now(wave_s); asm volatile("" : "+v"(tid_));
    const int tid = tid_, wid = tid >> 6, lane = tid & 63, r32 = lane & 31, hi = lane >> 5;
    const int widu = __builtin_amdgcn_readfirstlane(wid);
    LAS unsigned char* ldsl = (LAS unsigned char*)lds;
    char* V_lds = lds + OFF_V; char* K_lds = lds + OFF_K; char* Kr_lds = lds + OFF_KRL;
    float* ws = (float*)(lds + OFF_WSF) + wid * 64; float* li_l = ws; float* al_l = ws + 32;
    const float* bt = (const float*)(lds + OFF_BT);
    float m_reg = MLA ? -1e30f : sink, l_reg = MLA ? 0.f : 1.f; f32x16 o[4] = {}; bf16x8 qr[NQ];
    const bf16_t* Qw = Qb + (long)(wid * QBLK + r32) * ldq + hi * 8;
#pragma unroll
    for (int d0 = 0; d0 < NQ; ++d0) qr[d0] = *(const GAS bf16x8*)(Qw + d0 * 16);
    int koff, voff, kroff;
    { const int b = wid * 1024 + lane * 16;
      { const int row = b >> 8, cB = (b & 255) ^ ((row & 7) << 4); koff = row * ldk + (cB >> 1); }
      { const int sub = b >> 9, kk = (sub >> 2) * 8 + ((b & 511) >> 6), c = (sub & 3) * 32 + ((b & 63) >> 1), k = (kk & ~0xC) | ((kk & 4) << 1) | ((kk & 8) >> 1); voff = k * ldk + c; }
      { const int row = b >> 7, cB = (b & 127) ^ ((row & 7) << 4); kroff = row * ROPE + (cB >> 1); } }
    const int vb0 = (int)(uintptr_t)V_lds + v_rd_base(lane);
    const int relq = rel0 - wid * QBLK - r32;
#define DMA_K(t, s) do { const bf16_t* kp_ = Kh + (long)(t) * KVBLK * ldk; \
    __builtin_amdgcn_global_load_lds((const unsigned*)(kp_ + koff), (LAS unsigned*)(ldsl + OFF_K + (s) * SHM_K + widu * 1024), 16, 0, 0); \
    __builtin_amdgcn_global_load_lds((const unsigned*)(kp_ + 32 * ldk + koff), (LAS unsigned*)(ldsl + OFF_K + (s) * SHM_K + 8192 + widu * 1024), 16, 0, 0); \
    if constexpr (MLA) __builtin_amdgcn_global_load_lds((const unsigned*)(Krh + (long)(t) * KVBLK * ROPE + kroff), (LAS unsigned*)(ldsl + OFF_KRL + (s) * SHM_KR + widu * 1024), 16, 0, 0); } while (0)
#define DMA_V(t, s) do { const bf16_t* vp_ = Vh + (long)(t) * KVBLK * ldk; \
    __builtin_amdgcn_global_load_lds((const unsigned*)(vp_ + voff), (LAS unsigned*)(ldsl + OFF_V + (s) * SHM_V + widu * 1024), 16, 0, 0); \
    __builtin_amdgcn_global_load_lds((const unsigned*)(vp_ + 32 * ldk + voff), (LAS unsigned*)(ldsl + OFF_V + (s) * SHM_V + 8192 + widu * 1024), 16, 0, 0); } while (0)
#define WAITBAR_FULL() asm volatile("s_waitcnt vmcnt(0) lgkmcnt(0)\n\ts_barrier" ::: "memory")
#define WAITBAR_G1() do { if constexpr (MLA) asm volatile("s_waitcnt vmcnt(5) lgkmcnt(0)\n\ts_barrier" ::: "memory"); else asm volatile("s_waitcnt vmcnt(4) lgkmcnt(0)\n\ts_barrier" ::: "memory"); } while (0)
#define WAITBAR_G2() do { if constexpr (MLA) asm volatile("s_waitcnt vmcnt(10) lgkmcnt(0)\n\ts_barrier" ::: "memory"); else asm volatile("s_waitcnt vmcnt(8) lgkmcnt(0)\n\ts_barrier" ::: "memory"); } while (0)
#define RESC(a) do { if (__any((a) < 1.f)) { if (hi == 0) al_l[r32] = (a); asm volatile("s_waitcnt lgkmcnt(0)" ::: "memory"); \
    _Pragma("unroll") for (int d = 0; d < 4; ++d) _Pragma("unroll") for (int r = 0; r < 16; ++r) o[d][r] *= al_l[crow(r, hi)]; } } while (0)
#define FIX(P0, P1, t) do { if constexpr (!MLA) swa_fix(P0, P1, bt, relq + (t) * KVBLK, hi); } while (0)
#define ROT() do { sp = sc; sc = sn; sn = (sn == 2) ? 0 : sn + 1; } while (0)
    f32x16 pA0, pA1, pB0, pB1; float mnA, mnB, alA, alB, ps0; bf16x8 pa0, pa1, pa2, pa3;
    f32x16 negm = f32x16{}; if constexpr (MLA) { m_reg = 0.f; asm volatile("" : "+v"(negm)); }
#define PSM(P0, P1, MN, AL, FIRST) do { if constexpr (MLA) partialSM_mla<FIRST>(P0, P1, m_reg, negm, AL); else partialSM<false>(P0, P1, m_reg, MN, AL); pack_p0(P0, pa0, pa1, ps0); } while (0)
    int sp = 2, sc = 0, sn = 1;
    DMA_K(0, 0); DMA_K(1, 1); DMA_V(0, 0); DMA_K(2, 2); DMA_V(1, 1);
    WAITBAR_G2();
    qkt<MLA>(pA0, pA1, K_lds, Kr_lds, qr, r32, hi, negm); FIX(pA0, pA1, 0); PSM(pA0, pA1, mnA, alA, true);
    WAITBAR_G1();
    DMA_K(3, 0); DMA_V(2, 2);
    ROT();
    for (int j = 1; j + 1 < NT; j += 2) {
        SBAR(); qkt_fin<MLA>(pB0, pB1, K_lds + sc * SHM_K, Kr_lds + sc * SHM_KR, qr, r32, hi, negm, pA1, alA, l_reg, ps0, pa2, pa3); FIX(pB0, pB1, j); SBAR();
        pv_d0(o, vb0 + sp * SHM_V, pa0, pa1, pa2, pa3); PSM(pB0, pB1, mnB, alB, false);
        RESC(alB);
        WAITBAR_G1();
        if (j + 3 < NT) DMA_K(j + 3, sc); DMA_V(j + 2, sp);
        ROT();
        SBAR(); qkt_fin<MLA>(pA0, pA1, K_lds + sc * SHM_K, Kr_lds + sc * SHM_KR, qr, r32, hi, negm, pB1, alB, l_reg, ps0, pa2, pa3); FIX(pA0, pA1, j + 1); SBAR();
        pv_d0(o, vb0 + sp * SHM_V, pa0, pa1, pa2, pa3); PSM(pA0, pA1, mnA, alA, false);
        RESC(alA);
        if (j + 3 < NT) { WAITBAR_G1(); } else { WAITBAR_FULL(); }
        if (j + 4 < NT) DMA_K(j + 4, sc); if (j + 3 < NT) DMA_V(j + 3, sp);
        ROT();
    }
    SBAR(); qkt_fin<MLA>(pB0, pB1, K_lds + sc * SHM_K, Kr_lds + sc * SHM_KR, qr, r32, hi, negm, pA1, alA, l_reg, ps0, pa2, pa3); FIX(pB0, pB1, NT - 1); SBAR();
    pv_d0(o, vb0 + sp * SHM_V, pa0, pa1, pa2, pa3); PSM(pB0, pB1, mnB, alB, false);
    RESC(alB);
    fin_p1(pB1, alB, l_reg, ps0, pa2, pa3); SBAR();
    pv_d0(o, vb0 + sc * SHM_V, pa0, pa1, pa2, pa3);
    if (hi == 0) li_l[r32] = l_reg; asm volatile("s_waitcnt lgkmcnt(0)" ::: "memory");
    float rli[16];
#pragma unroll
    for (int r = 0; r < 16; ++r) rli[r] = __builtin_amdgcn_rcpf(li_l[crow(r, hi)]);
    bf16_t* Ow = Ob + (long)(wid * QBLK) * ldo;
#pragma unroll
    for (int r = 0; r < 16; ++r) { const int orow = crow(r, hi);
#pragma unroll
        for (int d0 = 0; d0 < 4; ++d0) *(GAS bf16_t*)(Ow + (long)orow * ldo + d0 * 32 + r32) = (bf16_t)(cvt_pk_bf16(o[d0][r] * rli[r], 0.f) & 0xffffu); }
    WAITBAR_FULL();
#undef DMA_K
#undef DMA_V
#undef WAITBAR_FULL
#undef WAITBAR_G1
#undef WAITBAR_G2
#undef RESC
#undef FIX
#undef ROT
#undef PSM
}
}

#define XB_TMO      128
#define XB_XCNT(j)  (256  + 64 * (j))
#define XB_XSUB(j)  (1280 + 64 * (j))
#define XB_XGEN(j)  (2304 + 64 * (j))
#define XB_TOP      3328
#define XB_TOPGEN   3392
#define XCD_BAR_WORDS 3456
#define XB_SPIN_CAP (1u << 22)
__device__ __forceinline__ unsigned xb_ld(unsigned* p)              { return __hip_atomic_load(p, __ATOMIC_RELAXED, __HIP_MEMORY_SCOPE_AGENT); }
__device__ __forceinline__ unsigned xb_add(unsigned* p, unsigned v) { return __hip_atomic_fetch_add(p, v, __ATOMIC_RELAXED, __HIP_MEMORY_SCOPE_AGENT); }
__device__ __forceinline__ unsigned xb_xcc_id() { return (unsigned)__builtin_amdgcn_s_getreg((3 << 11) | 20) & 0xFu; }
#define XB_SPIN(cond, bar) do { unsigned _sp = 0; while (cond) { __builtin_amdgcn_s_sleep(1); \
    if ((++_sp & 255u) == 0u) { if (xb_ld(&(bar)[XB_TMO])) break; if (_sp > XB_SPIN_CAP) { atomicAdd(&(bar)[XB_TMO], 1u); break; } } } } while (0)
struct XcdBarrier { unsigned* bar; unsigned x; volatile LAS unsigned* st; };
__device__ __forceinline__ XcdBarrier xcd_barrier_post(unsigned* bar, volatile LAS unsigned* st, int wave_s) {
    XcdBarrier b; b.bar = bar; b.x = xb_xcc_id(); b.st = st;
    if (tid_now(wave_s) == 0) (void)xb_add(&bar[XB_XCNT(b.x)], 1u);
    return b;
}
__device__ __forceinline__ void xcd_barrier_complete(unsigned* bar, unsigned x, unsigned& nloc, unsigned& nx) {
    const unsigned G = gridDim.x * gridDim.y * gridDim.z;
    unsigned sum, cnt, mine, sp = 0u;
    for (;;) {
        sum = 0u; cnt = 0u; mine = 0u;
#pragma unroll
        for (unsigned j = 0; j < 16; ++j) { const unsigned c = xb_ld(&bar[XB_XCNT(j)]); sum += c; cnt += (c > 0u) ? 1u : 0u; mine = (j == x) ? c : mine; }
        if (sum == G) break;
        __builtin_amdgcn_s_sleep(1);
        if ((++sp & 255u) == 0u) { if (xb_ld(&bar[XB_TMO])) break; if (sp > XB_SPIN_CAP) { atomicAdd(&bar[XB_TMO], 1u); break; } }
    }
    nloc = mine > 0u ? mine : 1u; nx = cnt > 0u ? cnt : 1u;
}
__device__ __forceinline__ void xcd_barrier(const XcdBarrier& b, int wave_s) {
    asm volatile("s_waitcnt vmcnt(0)" ::: "memory");
    __syncthreads();
    if (tid_now(wave_s) == 0) {
        unsigned* bar = b.bar;
        __builtin_amdgcn_s_waitcnt(0);
        unsigned nloc = b.st[0], nx = b.st[1];
        if (nloc == 0u) { xcd_barrier_complete(bar, b.x, nloc, nx); b.st[0] = nloc; b.st[1] = nx; }
        const unsigned old = xb_add(&bar[XB_XSUB(b.x)], 1u);
        const unsigned gen = old / nloc;
        if (old + 1u == (gen + 1u) * nloc) {
            __builtin_amdgcn_fence(__ATOMIC_RELEASE, "agent");
            asm volatile("s_waitcnt vmcnt(0)" ::: "memory");
            const unsigned og = xb_add(&bar[XB_TOP], 1u);
            const unsigned tg = og / nx;
            if (og + 1u == (tg + 1u) * nx) xb_add(&bar[XB_TOPGEN], 1u);
            else XB_SPIN(xb_ld(&bar[XB_TOPGEN]) == tg, bar);
            __builtin_amdgcn_fence(__ATOMIC_ACQUIRE, "agent");
            xb_add(&bar[XB_XGEN(b.x)], 1u);
            asm volatile("s_waitcnt vmcnt(0)" ::: "memory");
        } else {
            XB_SPIN(xb_ld(&bar[XB_XGEN(b.x)]) == gen, bar);
            __builtin_amdgcn_fence(__ATOMIC_ACQUIRE, "agent");
            asm volatile("s_waitcnt vmcnt(0)" ::: "memory");
        }
    }
    __syncthreads();
}

constexpr int NWAVES = 8;
constexpr int LDS_BYTES = 147456, LDSCTL_OFF = 131072;
static_assert(att::LDS_END <= pg8::STAGE_BYTES && pg8::STAGE_BYTES <= LDS_BYTES, "LDS map");

struct Args {
    const float* x; const float* p; const int* pos;
    const float* attn_norm; const float* w_in; const float* cq_norm; const float* ckv_norm; const float* w_uq; const float* w_ukv;
    const float* sink; const float* t5; const float* mla_on; const float* swa_on; const float* w_o; const float* ffn_norm;
    const float* w_gate; const float* w_up; const float* conv_w; const float* conv_b; const float* w_down;
    const float* pg_w; const float* pg_b; const float* pp_w; const float* final_norm;
    float* out; unsigned char* ws; int ph_lo, ph_hi;
};

template <int MODE>
__device__ __forceinline__ void transpose_item(const float* W, int K, int N, bf16_t* WT, int row_off, const float* kscale, LAS float* scr, int item, int lane) {
    const int nblk = N / 32, kb = item / nblk, nb = item % nblk, k0 = 64 * kb, n0 = 32 * nb;
    float tv[32];
#pragma unroll
    for (int i = 0; i < 32; ++i) { const int kk = 2 * i + (lane >> 5); tv[i] = *(const GAS float*)(W + (size_t)(k0 + kk) * N + n0 + (lane & 31)); }
#pragma unroll
    for (int i = 0; i < 32; ++i) { const int kk = 2 * i + (lane >> 5); float v = tv[i]; if (kscale) v *= kscale[k0 + kk]; scr[kk * 33 + (lane & 31)] = v; }
    asm volatile("s_waitcnt lgkmcnt(0)" ::: "memory");
    const int c = lane & 7;
#pragma unroll
    for (int j = 0; j < 4; ++j) { const int n = (lane >> 3) + 8 * j; const LAS float* s = scr + (8 * c) * 33 + n;
        u32x4 o; o.x = cvt_pk_bf16(s[0 * 33], s[1 * 33]); o.y = cvt_pk_bf16(s[2 * 33], s[3 * 33]); o.z = cvt_pk_bf16(s[4 * 33], s[5 * 33]); o.w = cvt_pk_bf16(s[6 * 33], s[7 * 33]);
        int nn = n0 + n;
        if (MODE == 1) { const int h = nn / 192, d = nn % 192; if (d >= 128) { const int e = d - 128; nn = h * 192 + 128 + 2 * (e & 31) + (e >> 5); } }
        if (MODE == 2) nn = (nn >> 7) * 256 + (nn & 127);
        *(GAS u32x4*)(WT + (size_t)(row_off + nn) * K + k0 + 8 * c) = o; }
    asm volatile("s_waitcnt lgkmcnt(0)" ::: "memory");
}

__device__ __forceinline__ int t5_bucket(int rel) {
    const int ret = rel > 0 ? 16 : 0; const int n = rel < 0 ? -rel : rel;
    if (n < 8) return ret + n;
    int large = 33 - __clz(n * n); if (large > 15) large = 15;
    return ret + large;
}

__global__ void __launch_bounds__(NWAVES * 64, 2) mk_fwd(Args a) {
    extern __shared__ __attribute__((aligned(16))) unsigned char lds[];
    cg::grid_group grid = cg::this_grid();
    const int G = gridDim.x, bx = blockIdx.x;
    const int vcu = (G % 8 == 0) ? (bx % 8) * (G / 8) + bx / 8 : bx;
    const int NGW = G * NWAVES;
    const int wave_s = __builtin_amdgcn_readfirstlane((int)threadIdx.x >> 6);
    { volatile LAS unsigned* ctl = (volatile LAS unsigned*)((LAS unsigned char*)lds + LDSCTL_OFF); const int t0 = tid_now(wave_s); if (t0 < 16) ctl[t0] = 0u; }
    __syncthreads();
    const XcdBarrier xbar = xcd_barrier_post((unsigned*)(a.ws + WS_BAR), (volatile LAS unsigned*)((LAS unsigned char*)lds + LDSCTL_OFF) + 8, wave_s);
    bool first_seam = true;
#define PHASE_IDS() int tid_ = tid_now(wave_s); asm volatile("" : "+v"(tid_)); const int tid = tid_, lane = tid & 63, wave = __builtin_amdgcn_readfirstlane(tid >> 6), gw = vcu * NWAVES + wave; (void)tid; (void)lane; (void)gw
    for (int ph2 = a.ph_lo * 2; ph2 < a.ph_hi * 2; ++ph2) {
        const int ph = ph2 >> 1;
        if (MK_DUP < 0 && (ph2 & 1)) continue;
        if (MK_DUP >= 0 && (ph2 & 1) && (ph % NPH_LAYER != MK_DUP || ph == NPHASE - 1)) continue;
        if (ph != NPHASE - 1 && ph % NPH_LAYER == 7) continue;
        if (ph2 > a.ph_lo * 2) { if (first_seam) { grid.sync(); first_seam = false; } else xcd_barrier(xbar, wave_s); }
    unsigned char* ws = a.ws; asm volatile("" : "+s"(ws));
    u64_t* ssq0 = (u64_t*)(ws + WS_SSQ0); u64_t* ssq1 = (u64_t*)(ws + WS_SSQ1); bf16_t* XB0 = (bf16_t*)(ws + WS_XB0); bf16_t* XB1 = (bf16_t*)(ws + WS_XB1);
    float* rsq = (float*)(ws + WS_RSQ); float* rskv = (float*)(ws + WS_RSKV); float* cst = (float*)(ws + WS_COS); float* snt = (float*)(ws + WS_SIN);
    bf16_t* KR = (bf16_t*)(ws + WS_KR); bf16_t* PB = (bf16_t*)(ws + WS_PB);
    bf16_t* Win_t = (bf16_t*)(ws + W_IN); bf16_t* Wuq_t = (bf16_t*)(ws + W_UQ); bf16_t* Wukv_t = (bf16_t*)(ws + W_UKV); bf16_t* Wo_t = (bf16_t*)(ws + W_O);
    bf16_t* Wgu_t = (bf16_t*)(ws + W_GU); bf16_t* Wd_t = (bf16_t*)(ws + W_D); bf16_t* Wpg_t = (bf16_t*)(ws + W_PG); bf16_t* Wpp_t = (bf16_t*)(ws + W_PP);
    bf16_t* H = (bf16_t*)(ws + WS_H); bf16_t* Z = (bf16_t*)(ws + WS_Z); bf16_t* Q = (bf16_t*)(ws + WS_Q); bf16_t* KV = (bf16_t*)(ws + WS_KV);
    bf16_t* ACT = (bf16_t*)(ws + WS_ACT); bf16_t* SBG = (bf16_t*)(ws + WS_SBG); bf16_t* SBU = (bf16_t*)(ws + WS_SBU); bf16_t* PG = (bf16_t*)(ws + WS_PG);
    LAS unsigned char* ldsl = (LAS unsigned char*)lds;

        const int L = ph / NPH_LAYER, q = (ph == NPHASE - 1) ? 99 : ph % NPH_LAYER;
        const float* xin = (L == 0) ? a.x : a.out;
        if (q == 0 && EN(0)) {
            PHASE_IDS();
            LAS float* scr = (LAS float*)(ldsl + wave * 16384);
            constexpr int I_IN = (DM / 64) * (INW / 32), I_UQ = (QRANK / 64) * (QW / 32), I_UKV = (KVRANK / 64) * (KVW / 32), I_O = (DM / 64) * (DM / 32),
                          I_G = (DM / 64) * (FF / 32), I_D = (FF / 64) * (DM / 32), I_PG = I_O, I_PP = (PLE / 64) * (DM / 32);
            constexpr int NITEMS = I_IN + I_UQ + I_UKV + I_O + 2 * I_G;
            (void)I_D; (void)I_PG; (void)I_PP;
            for (int it = gw; it < NITEMS; it += NGW) {
                int r = it;
                if (r < I_IN) { transpose_item<0>(a.w_in + (size_t)L * DM * INW, DM, INW, Win_t, 0, a.attn_norm + L * DM, scr, r, lane); continue; } r -= I_IN;
                if (r < I_UQ) { transpose_item<1>(a.w_uq + (size_t)L * QRANK * QW, QRANK, QW, Wuq_t, 0, a.cq_norm + L * QRANK, scr, r, lane); continue; } r -= I_UQ;
                if (r < I_UKV) { transpose_item<0>(a.w_ukv + (size_t)L * KVRANK * KVW, KVRANK, KVW, Wukv_t, 0, a.ckv_norm + L * KVRANK, scr, r, lane); continue; } r -= I_UKV;
                if (r < I_O) { transpose_item<0>(a.w_o + (size_t)L * DM * DM, DM, DM, Wo_t, 0, nullptr, scr, r, lane); continue; } r -= I_O;
                if (r < I_G) { transpose_item<2>(a.w_gate + (size_t)L * DM * FF, DM, FF, Wgu_t, 0, a.ffn_norm + L * DM, scr, r, lane); continue; } r -= I_G;
                transpose_item<2>(a.w_up + (size_t)L * DM * FF, DM, FF, Wgu_t, 128, a.ffn_norm + L * DM, scr, r, lane);
            }
            { const unsigned z0 = opaque_zero(); const u32x4 zv = {z0, z0, z0, z0};
              for (int i = gw * 64 + lane; i < (ZW - INW) * DM / 8; i += NGW * 64) *(u32x4*)(Win_t + (size_t)INW * DM + (size_t)i * 8) = zv; }
        }
        if (q == 0 && L == 0 && EN(7)) {
            PHASE_IDS();
            for (int m = gw; m < T; m += NGW) { const GAS f32x4* xr = (const GAS f32x4*)(a.x + (size_t)m * DM) + lane; f32x4 v[8]; float sm = 0.f;
#pragma unroll
                for (int j = 0; j < 8; ++j) { v[j] = xr[64 * j]; sm += (v[j].x * v[j].x + v[j].y * v[j].y) + (v[j].z * v[j].z + v[j].w * v[j].w); }
                sm = wave_sum(sm, lane); if (lane == 0) ssq0[m] = (u64_t)(sm * SSQ_FX + 0.5f);
                GAS u32x2* o8 = (GAS u32x2*)(XB0 + (size_t)m * DM) + lane;
#pragma unroll
                for (int j = 0; j < 8; ++j) { u32x2 w; w.x = cvt_pk_bf16(v[j].x, v[j].y); w.y = cvt_pk_bf16(v[j].z, v[j].w); o8[64 * j] = w; } }
        }
        if (q == 0) { }
        else if (q == 1 && EN(1)) {
            pg8::Gemm g{XB0, Win_t, T, ZW, DM, DM}; pg8::StaticOrder S; S.init(T, ZW, G, bx);
            pg8::EpiBf16 E{Z, ZW, nullptr, ssq0};
            pg8::gemm_phase<pg8::EpiBf16, true>(ldsl, g, S, E, wave_s);
            { const int nwg = (T / 256) * (ZW / 256), rounds = (nwg + G - 1) / G, nI0 = rounds * G - nwg;
              const bool idle = (nI0 == 0) || ((long)(rounds - 1) * G + bx >= nwg);
              if (idle) { PHASE_IDS(); (void)tid;
                const int nI = nI0 == 0 ? G : nI0, ib = nI0 == 0 ? bx : bx - (G - nI0);
                const int gwI = ib * NWAVES + wave, NGWI = nI * NWAVES;
                LAS float* scr = (LAS float*)(ldsl + wave * 16384);
                constexpr int I_D = (FF / 64) * (DM / 32), I_PG = (DM / 64) * (DM / 32), I_PP = (PLE / 64) * (DM / 32);
                for (int it = gwI; it < I_D + I_PG + I_PP; it += NGWI) { int r = it;
                    if (r < I_D) { transpose_item<0>(a.w_down + (size_t)L * FF * DM, FF, DM, Wd_t, 0, nullptr, scr, r, lane); continue; } r -= I_D;
                    if (r < I_PG) { transpose_item<0>(a.pg_w + (size_t)L * DM * DM, DM, DM, Wpg_t, 0, nullptr, scr, r, lane); continue; } r -= I_PG;
                    transpose_item<0>(a.pp_w + (size_t)L * PLE * DM, PLE, DM, Wpp_t, 0, nullptr, scr, r, lane); }
                const float* pl = a.p + (size_t)L * T * PLE;
                for (size_t i = (size_t)gwI * 64 + lane; i < (size_t)T * PLE / 8; i += (size_t)NGWI * 64) { const f32x4 v0 = *(const GAS f32x4*)(pl + i * 8), v1 = *(const GAS f32x4*)(pl + i * 8 + 4);
                    u32x4 w; w.x = cvt_pk_bf16(v0[0], v0[1]); w.y = cvt_pk_bf16(v0[2], v0[3]); w.z = cvt_pk_bf16(v1[0], v1[1]); w.w = cvt_pk_bf16(v1[2], v1[3]); *(GAS u32x4*)(PB + i * 8) = w; } } }
        }
        else if (q == 2 && EN(2)) {
            PHASE_IDS();
            for (int m = gw; m < T; m += NGW) { const bf16_t* zr = Z + (size_t)m * ZW;
                float s1 = 0.f, s2 = 0.f;
                if (lane < 48) { const u32x4 w = *(const u32x4*)(zr + OFF_CQ + lane * 8);
#pragma unroll
                    for (int i = 0; i < 4; ++i) { const float lo = bf_lo(w[i]), hi = bf_hi(w[i]); s1 += lo * lo + hi * hi; } }
                if (lane < 32) { const u32x4 w = *(const u32x4*)(zr + OFF_CKV + lane * 8);
#pragma unroll
                    for (int i = 0; i < 4; ++i) { const float lo = bf_lo(w[i]), hi = bf_hi(w[i]); s2 += lo * lo + hi * hi; } }
                s1 = wave_sum(s1, lane); s2 = wave_sum(s2, lane);
                if (lane == 0) { rsq[m] = rsqrtf(s1 * (1.f / QRANK) + EPS); rskv[m] = rsqrtf(s2 * (1.f / KVRANK) + EPS); ssq0[m] = 0ull; ssq1[m] = 0ull; }
                if (lane < 32) { float c, s;
                    if (L == 0) { double invf = 1.0, bb = 0.7498942093324559;
#pragma unroll
                        for (int bit = 0; bit < 5; ++bit) { if ((lane >> bit) & 1) invf *= bb; bb *= bb; }
                        const double rev = (double)a.pos[m] * invf * 0.15915494309189535; const float fr = (float)(rev - rint(rev));
                        c = __builtin_amdgcn_cosf(fr); s = __builtin_amdgcn_sinf(fr); cst[(size_t)m * 32 + lane] = c; snt[(size_t)m * 32 + lane] = s; }
                    else { c = cst[(size_t)m * 32 + lane]; s = snt[(size_t)m * 32 + lane]; }
                    const float k1 = __uint_as_float((unsigned)zr[OFF_KR + lane] << 16), k2 = __uint_as_float((unsigned)zr[OFF_KR + 32 + lane] << 16);
                    *(unsigned*)(KR + (size_t)m * ROPE + 2 * lane) = cvt_pk_bf16(k1 * c - k2 * s, k1 * s + k2 * c); } }
        }
        else if (q == 3 && EN(3)) {
            { pg8::Gemm g{Z + OFF_CQ, Wuq_t, T, QW, QRANK, ZW}; pg8::StaticOrder S; S.init(T, QW, G, bx);
              pg8::EpiQ E{Q, rsq, cst, snt};
              pg8::gemm_phase<pg8::EpiQ, true>(ldsl, g, S, E, wave_s); }
            { pg8::Gemm g{Z + OFF_CKV, Wukv_t, T, KVW, KVRANK, ZW}; pg8::StaticOrder S; S.init(T, KVW, G, bx);
              pg8::EpiBf16 E{KV, KVW, rskv, nullptr};
              pg8::gemm_phase<pg8::EpiBf16, true>(ldsl, g, S, E, wave_s); }
        }
        else if (q == 4 && EN(4)) {
            constexpr int NQB = SEQ / 256, NU = BATCH * NH * NQB;
            for (int u = vcu; u < NU; u += G) { const int bh = u / NQB, qb = u % NQB, b = bh / NH, h = bh % NH; const size_t row0 = (size_t)b * SEQ;
                att::attn_unit<true, QW, KVW, DM>(Q + (row0 + (size_t)qb * 256) * QW + h * 192, KV + row0 * KVW + h * 256, KV + row0 * KVW + h * 256 + 128, KR + row0 * ROPE,
                                        H + (row0 + (size_t)qb * 256) * DM + h * 128, SEQ / 64, (char*)lds, 0, 0.f, wave_s); }
            for (int u = vcu; u < NU; u += G) { PHASE_IDS(); const int bh = u / NQB, qb = u % NQB, b = bh / NH, h = bh % NH, kvh = h >> 2; const size_t row0 = (size_t)b * SEQ;
                const int q0 = qb * 256, key0 = q0 >= 128 ? q0 - 128 : 0, kend = (q0 + 384 <= SEQ) ? q0 + 384 : SEQ, NT = (kend - key0) / 64;
                for (int i = tid; i < 768; i += NWAVES * 64) { const int rel = i - 384; ((float*)(lds + att::OFF_BT))[i] = (rel >= -128 && rel <= 128) ? a.t5[t5_bucket(rel) * NH + h] : -1e30f; }
                __syncthreads();
                att::attn_unit<false, ZW, ZW, DM>(Z + (row0 + q0) * ZW + OFF_SQ + h * 128, Z + (row0 + key0) * ZW + OFF_SK + kvh * 128, Z + (row0 + key0) * ZW + OFF_SV + kvh * 128, nullptr,
                                         H + (row0 + q0) * DM + 1024 + h * 128, NT, (char*)lds, key0 - q0, a.sink[L * NH + h], wave_s); }
        }
        else if (q == 5 && EN(5)) {
            PHASE_IDS();
            f32x4 gv[4][2];
#pragma unroll
            for (int j = 0; j < 4; ++j) { const int col = (lane + 64 * j) * 8; const float* gs = (col < 1024) ? a.mla_on + L * 1024 + col : a.swa_on + L * 1024 + (col - 1024);
                gv[j][0] = *(const f32x4*)gs; gv[j][1] = *(const f32x4*)(gs + 4); }
            for (int m = gw; m < T; m += NGW) { u32x4* hr = (u32x4*)(H + (size_t)m * DM) + lane; u32x4 w[4]; float s1 = 0.f, s2 = 0.f;
#pragma unroll
                for (int j = 0; j < 4; ++j) { w[j] = hr[64 * j]; float s = 0.f;
#pragma unroll
                    for (int i = 0; i < 4; ++i) { const float lo = bf_lo(w[j][i]), hi = bf_hi(w[j][i]); s += lo * lo + hi * hi; }
                    if (j < 2) s1 += s; else s2 += s; }
                s1 = wave_sum(s1, lane); s2 = wave_sum(s2, lane);
                const float r1 = rsqrtf(s1 * (1.f / 1024) + EPS), r2 = rsqrtf(s2 * (1.f / 1024) + EPS);
#pragma unroll
                for (int j = 0; j < 4; ++j) { const float rr = j < 2 ? r1 : r2; u32x4 o;
#pragma unroll
                    for (int i = 0; i < 4; ++i) { const float g0 = (i < 2) ? gv[j][0][2 * i] : gv[j][1][2 * i - 4], g1 = (i < 2) ? gv[j][0][2 * i + 1] : gv[j][1][2 * i - 3];
                        o[i] = cvt_pk_bf16(bf_lo(w[j][i]) * rr * g0, bf_hi(w[j][i]) * rr * g1); }
                    hr[64 * j] = o; } }
        }
        else if (q == 6 && EN(6)) {
            pg8::Gemm g{H, Wo_t, T, DM, DM, DM}; pg8::StaticOrder S; S.init(T, DM, G, bx);
            pg8::EpiRes E{a.x, (L == 0) ? nullptr : XB0, nullptr, XB1, ssq1};
            pg8::gemm_phase<pg8::EpiRes, true>(ldsl, g, S, E, wave_s);
        }
        else if (q == 8 && EN(8)) {
            pg8::Gemm g{XB1, Wgu_t, T, GUW, DM, DM}; pg8::StaticOrder S; S.init(T, GUW, G, bx);
            pg8::EpiGU E{ACT, SBG, SBU, a.conv_w + (size_t)L * 3 * FF, a.conv_b + (size_t)L * FF, (LAS float*)(ldsl + 132096), ssq1};
            pg8::gemm_phase<pg8::EpiGU, true>(ldsl, g, S, E, wave_s);
        }
        else if (q == 9 && EN(9)) {
            PHASE_IDS();
            constexpr int NCC = FF / 8, NIT = (T / 256) * 2 * NCC; const float* cw = a.conv_w + (size_t)L * 3 * FF; const float* cb = a.conv_b + (size_t)L * FF;
            for (int it = gw * 64 + lane; it < NIT; it += NGW * 64) { const int cc = it % NCC, rw = it / NCC, pm = rw >> 1, which = rw & 1, f0 = cc * 8;
                const size_t R = (size_t)pm * 256 + (which ? 255 : 0); const int sq = (int)(R % SEQ);
                const unsigned z0 = opaque_zero(); const u32x4 zv = {z0, z0, z0, z0};
                u32x4 gp, gc, gn, uu;
                if (which == 0) { gp = (sq == 0) ? zv : *(const GAS u32x4*)(SBG + ((size_t)(pm - 1) * 4 + 3) * FF + f0); gc = *(const GAS u32x4*)(SBG + ((size_t)pm * 4 + 0) * FF + f0); gn = *(const GAS u32x4*)(SBG + ((size_t)pm * 4 + 1) * FF + f0); }
                else { gp = *(const GAS u32x4*)(SBG + ((size_t)pm * 4 + 2) * FF + f0); gc = *(const GAS u32x4*)(SBG + ((size_t)pm * 4 + 3) * FF + f0); gn = (sq == SEQ - 1) ? zv : *(const GAS u32x4*)(SBG + ((size_t)(pm + 1) * 4 + 0) * FF + f0); }
                uu = *(const GAS u32x4*)(SBU + ((size_t)pm * 2 + which) * FF + f0); u32x4 o;
#pragma unroll
                for (int i = 0; i < 4; ++i) { const int f = f0 + 2 * i;
                    const float ga = bf_lo(gp[i]) * cw[f] + bf_lo(gc[i]) * cw[FF + f] + bf_lo(gn[i]) * cw[2 * FF + f] + cb[f];
                    const float gb = bf_hi(gp[i]) * cw[f + 1] + bf_hi(gc[i]) * cw[FF + f + 1] + bf_hi(gn[i]) * cw[2 * FF + f + 1] + cb[f + 1];
                    const float sa = ga * __builtin_amdgcn_rcpf(1.f + __expf(-ga)), sb = gb * __builtin_amdgcn_rcpf(1.f + __expf(-gb));
                    o[i] = cvt_pk_bf16(sa * bf_lo(uu[i]), sb * bf_hi(uu[i])); }
                *(GAS u32x4*)(ACT + R * FF + f0) = o; }
        }
        else if (q == 10 && EN(10)) {
            pg8::Gemm g{ACT, Wd_t, T, DM, FF, FF}; pg8::StaticOrder S; S.init(T, DM, G, bx);
            pg8::EpiRes E{nullptr, XB1, nullptr, H, nullptr};
            pg8::gemm_phase<pg8::EpiRes, true>(ldsl, g, S, E, wave_s);
        }
        else if (q == 11 && EN(11)) {
            pg8::Gemm g{PB, Wpp_t, T, DM, PLE, PLE}; pg8::StaticOrder S; S.init(T, DM, G, bx);
            pg8::EpiBf16 E{PG, DM, nullptr, nullptr};
            pg8::gemm_phase<pg8::EpiBf16, true>(ldsl, g, S, E, wave_s);
            asm volatile("s_waitcnt vmcnt(0)" ::: "memory"); __syncthreads();
        }
        if (q == 11 && EN(12)) {
            pg8::Gemm g{H, Wpg_t, T, DM, DM, DM}; pg8::StaticOrder S; S.init(T, DM, G, bx);
            pg8::EpiPle E{H, nullptr, a.pg_b + L * DM, PG, XB0, ssq0};
            pg8::gemm_phase<pg8::EpiPle, true>(ldsl, g, S, E, wave_s);
        }
        else if (q == 99 && EN(13)) {
            PHASE_IDS();
            f32x4 gv[4][2];
#pragma unroll
            for (int j = 0; j < 4; ++j) { gv[j][0] = *(const GAS f32x4*)(a.final_norm + (lane + 64 * j) * 8); gv[j][1] = *(const GAS f32x4*)(a.final_norm + (lane + 64 * j) * 8 + 4); }
            for (int m = gw; m < T; m += NGW) { const GAS u32x4* xr = (const GAS u32x4*)(XB0 + (size_t)m * DM) + lane; u32x4 w[4];
#pragma unroll
                for (int j = 0; j < 4; ++j) w[j] = xr[64 * j];
                const float rstd = rsqrtf((float)*(const GAS u64_t*)(ssq0 + m) * (SSQ_INV / DM) + EPS);
                GAS f32x4* orow = (GAS f32x4*)(a.out + (size_t)m * DM);
#pragma unroll
                for (int j = 0; j < 4; ++j) { const f32x4 v0 = {bf_lo(w[j].x), bf_hi(w[j].x), bf_lo(w[j].y), bf_hi(w[j].y)}, v1 = {bf_lo(w[j].z), bf_hi(w[j].z), bf_lo(w[j].w), bf_hi(w[j].w)};
                    orow[(lane + 64 * j) * 2] = v0 * rstd * gv[j][0]; orow[(lane + 64 * j) * 2 + 1] = v1 * rstd * gv[j][1]; } }
        }
    }
}

extern "C" void kernel_launch(void* const* d_in, const int* in_sizes, int n_in, void* d_out, int out_size, void* d_ws, size_t ws_size, hipStream_t stream) {
    static int grid = 0;
    if (grid == 0) {
        if (n_in != 24 || out_size != T * DM || ws_size < WS_NEED) { fprintf(stderr, "kernel_launch: unexpected shapes (n_in %d out %d ws %zu need %zu)\n", n_in, out_size, ws_size, (size_t)WS_NEED); grid = -1; return; }
        int dev = 0, cus = 0, per_cu = 0;
        hipGetDevice(&dev); hipDeviceGetAttribute(&cus, hipDeviceAttributeMultiprocessorCount, dev);
        if (hipFuncSetAttribute((const void*)mk_fwd, hipFuncAttributeMaxDynamicSharedMemorySize, LDS_BYTES) != hipSuccess) { fprintf(stderr, "kernel_launch: hipFuncSetAttribute failed\n"); grid = -1; return; }
        if (hipOccupancyMaxActiveBlocksPerMultiprocessor(&per_cu, (const void*)mk_fwd, NWAVES * 64, LDS_BYTES) != hipSuccess || per_cu < 1) { fprintf(stderr, "kernel_launch: occupancy query says %d\n", per_cu); per_cu = 1; }
        (void)hipGetLastError();
        grid = cus * 1;
        fprintf(stderr, "kernel_launch: grid %d (cus %d, per_cu %d)\n", grid, cus, per_cu);
    }
    if (grid < 0) return;
    if (hipMemsetAsync((char*)d_ws + WS_BAR, 0, WS_BAR_BYTES, stream) != hipSuccess) { fprintf(stderr, "kernel_launch: memset failed\n"); return; }
    Args a{};
    a.x = (const float*)d_in[0]; a.p = (const float*)d_in[1]; a.pos = (const int*)d_in[2];
    a.attn_norm = (const float*)d_in[3]; a.w_in = (const float*)d_in[4]; a.cq_norm = (const float*)d_in[5]; a.ckv_norm = (const float*)d_in[6];
    a.w_uq = (const float*)d_in[7]; a.w_ukv = (const float*)d_in[8]; a.sink = (const float*)d_in[9]; a.t5 = (const float*)d_in[10];
    a.mla_on = (const float*)d_in[11]; a.swa_on = (const float*)d_in[12]; a.w_o = (const float*)d_in[13]; a.ffn_norm = (const float*)d_in[14];
    a.w_gate = (const float*)d_in[15]; a.w_up = (const float*)d_in[16]; a.conv_w = (const float*)d_in[17]; a.conv_b = (const float*)d_in[18]; a.w_down = (const float*)d_in[19];
    a.pg_w = (const float*)d_in[20]; a.pg_b = (const float*)d_in[21]; a.pp_w = (const float*)d_in[22]; a.final_norm = (const float*)d_in[23];
    a.out = (float*)d_out; a.ws = (unsigned char*)d_ws;
#if MK_MULTI
    for (int ph = 0; ph < NPHASE; ++ph) { a.ph_lo = ph; a.ph_hi = ph + 1; void* args[] = {&a};
        hipError_t e = hipLaunchCooperativeKernel((const void*)mk_fwd, dim3(grid), dim3(NWAVES * 64), args, LDS_BYTES, stream);
        if (e != hipSuccess) { fprintf(stderr, "kernel_launch: launch %d failed: %s\n", ph, hipGetErrorString(e)); break; } }
#else
    a.ph_lo = 0; a.ph_hi = NPHASE; void* args[] = {&a};
    hipError_t e = hipLaunchCooperativeKernel((const void*)mk_fwd, dim3(grid), dim3(NWAVES * 64), args, LDS_BYTES, stream);
    if (e != hipSuccess) fprintf(stderr, "kernel_launch: cooperative launch failed: %s (grid %d)\n", hipGetErrorString(e), grid);
#endif
}
```

```cpp
#include <hip/hip_runtime.h>
#include <hip/hip_cooperative_groups.h>
#include <cstdio>
#include <cstdint>
namespace cg = cooperative_groups;

#ifndef MK_PHMASK
#define MK_PHMASK 0xFFFFFFFFu
#endif
#define EN(k) (((MK_PHMASK) >> (k)) & 1u)
#ifndef MK_DUP
#define MK_DUP -1
#endif
#ifndef MK_MULTI
#define MK_MULTI 0
#endif

constexpr int BATCH = 2, SEQ = 16384, T = BATCH * SEQ, DM = 2048, DEPTH = 2, PLE = 256;
constexpr int QRANK = 384, KVRANK = 256, ROPE = 64, NH = 8;
constexpr int INW = 2240, ZW = 2304;
constexpr int OFF_CQ = 0, OFF_CKV = 384, OFF_KR = 640, OFF_SQ = 704, OFF_SK = 1728, OFF_SV = 1984;
constexpr int QW = 1536, KVW = 2048, FF = 5504, GUW = 2 * FF;
constexpr float EPS = 1e-6f;
constexpr int NPH_LAYER = 12, NPHASE = DEPTH * NPH_LAYER + 1;

constexpr size_t MiB = 1u << 20;
constexpr size_t WS_RSQ = 0, WS_RSKV = 256 * 1024, WS_COS = 1 * MiB, WS_SIN = 5 * MiB;
constexpr size_t WS_BAR = 512 * 1024, WS_BAR_BYTES = 16384;
constexpr size_t WS_SSQ0 = 896 * MiB, WS_SSQ1 = 897 * MiB;
constexpr float SSQ_FX = 65536.f, SSQ_INV = 1.f / 65536.f;
constexpr size_t WS_KR = 9 * MiB;
constexpr size_t WS_PB = 13 * MiB;
constexpr size_t WS_W = 29 * MiB;
constexpr size_t W_IN = WS_W, W_UQ = W_IN + (size_t)ZW * DM * 2, W_UKV = W_UQ + (size_t)QW * QRANK * 2, W_O = W_UKV + (size_t)KVW * KVRANK * 2,
                 W_GU = W_O + (size_t)DM * DM * 2, W_D = W_GU + (size_t)GUW * DM * 2, W_PG = W_D + (size_t)DM * FF * 2, W_PP = W_PG + (size_t)DM * DM * 2,
                 W_END = W_PP + (size_t)DM * PLE * 2;
constexpr size_t WS_H = 126 * MiB;
constexpr size_t WS_BIG = 254 * MiB;
constexpr size_t WS_Z = WS_BIG, WS_Q = WS_Z + (size_t)T * ZW * 2, WS_KV = WS_Q + (size_t)T * QW * 2, WS_KV_END = WS_KV + (size_t)T * KVW * 2;
constexpr size_t WS_ACT = WS_BIG, WS_ACT_END = WS_ACT + (size_t)T * FF * 2;
constexpr size_t WS_SBG = 622 * MiB, WS_SBU = WS_SBG + (size_t)(T / 256) * 4 * FF * 2, WS_SB_END = WS_SBU + (size_t)(T / 256) * 2 * FF * 2;
constexpr size_t WS_PG = WS_BIG;
constexpr size_t WS_XB1 = 640 * MiB, WS_XB0 = 768 * MiB, WS_NEED = WS_SSQ1 + (size_t)T * 8;
static_assert(W_END <= WS_H && WS_H + (size_t)T * DM * 2 <= WS_BIG && WS_KV_END <= WS_SBG && WS_ACT_END <= WS_SBG && WS_SB_END <= WS_XB1 && WS_NEED <= (size_t)1024 * MiB, "ws map");

#define LAS __attribute__((address_space(3)))
#define GAS __attribute__((address_space(1)))
typedef unsigned short bf16_t;
typedef short bf16x8 __attribute__((ext_vector_type(8)));
typedef short s16x4 __attribute__((ext_vector_type(4)));
typedef float f32x4 __attribute__((ext_vector_type(4)));
typedef float f32x8 __attribute__((ext_vector_type(8)));
typedef float f32x16 __attribute__((ext_vector_type(16)));
typedef unsigned u32x4 __attribute__((ext_vector_type(4)));
typedef unsigned u32x2 __attribute__((ext_vector_type(2)));
typedef unsigned long long u64_t;

__device__ __forceinline__ unsigned cvt_pk_bf16(float lo, float hi) { unsigned r; asm volatile("v_cvt_pk_bf16_f32 %0, %1, %2" : "=v"(r) : "v"(lo), "v"(hi)); return r; }
__device__ __forceinline__ int tid_now(int wave_s) { int z; asm volatile("v_mov_b32 %0, 0" : "=v"(z)); return wave_s * 64 + (int)__builtin_amdgcn_mbcnt_hi(~0u, __builtin_amdgcn_mbcnt_lo(~0u, (unsigned)z)); }
__device__ __forceinline__ unsigned opaque_zero() { unsigned z; asm volatile("v_mov_b32 %0, 0" : "=v"(z)); return z; }
__device__ __forceinline__ float bf_lo(unsigned w) { return __uint_as_float(w << 16); }
__device__ __forceinline__ float bf_hi(unsigned w) { return __uint_as_float(w & 0xffff0000u); }
__device__ __forceinline__ float wave_sum(float v, int lane) {
#pragma unroll
    for (int o = 1; o < 64; o <<= 1) v += __int_as_float(__builtin_amdgcn_ds_bpermute((lane ^ o) << 2, __float_as_int(v)));
    return v;
}

namespace pg8 {
constexpr int BM = 256, BK = 64, HALF = 128, HTB = HALF * BK * 2, STAGE_BYTES = 8 * HTB, NXCD = 8, WGM = 4;
__host__ __device__ __forceinline__ int lds_byte(int r, int c) { const int st = (r >> 4) * 2 + (c >> 5), rr = r & 15, cc = c & 31, ob = rr * 64 + cc * 2; return st * 1024 + (ob ^ (((ob >> 9) & 1) << 5)); }
__host__ __device__ __forceinline__ void stage_rc(int b, int& R, int& C) { const int st = b / 1024, sb = b % 1024, swz = sb ^ (((sb >> 9) & 1) << 5); R = (st >> 1) * 16 + swz / 64; C = (st & 1) * 32 + (swz % 64) / 2; }
__host__ __device__ __forceinline__ int perm32(int rho) { const int n = rho >> 4, i = rho & 15; return 8 * (i >> 2) + 4 * n + (i & 3); }

struct Unit { int pm, pn; };
struct Gemm { const bf16_t* A; const bf16_t* Bt; int M, N, K, lda; };

struct StaticOrder {
    int nM, nN, nwg, G, c;
    __device__ void init(int M, int N, int G_, int c_) { nM = M / BM; nN = N / BM; nwg = nM * nN; G = G_; c = c_; }
    __device__ bool next(int i, Unit& u) const {
        const long L = (long)i * G + c; if (L >= nwg) return false;
        int wgid = (int)L; { const int q = nwg / NXCD, r = nwg % NXCD, xcd = wgid % NXCD, off = wgid / NXCD; wgid = (xcd < r ? xcd * (q + 1) : r * (q + 1) + (xcd - r) * q) + off; }
        const int nig = WGM * nN, gid = wgid / nig, fm = gid * WGM, gsz = (nM - fm) < WGM ? (nM - fm) : WGM;
        u.pm = fm + ((wgid % nig) % gsz); u.pn = (wgid % nig) / gsz; return true;
    }
};

struct EpiBf16 {
    bf16_t* O; int ldc; const float* rs; const u64_t* ssqp;
    __device__ __forceinline__ void operator()(const f32x4 (&acc)[2][2][4][2], const Unit& u, int wr, int wc, int fr, int fq) const {
        const int row0 = u.pm * BM + wr * 64 + fr, col0 = u.pn * BM + wc * 32 + 8 * fq;
#pragma unroll
        for (int ai = 0; ai < 2; ++ai)
#pragma unroll
            for (int m = 0; m < 4; ++m) { const int r = row0 + ai * HALF + m * 16; float s = rs ? *(const GAS float*)(rs + r) : 1.f; if (ssqp) s = rsqrtf((float)*(const GAS u64_t*)(ssqp + r) * (SSQ_INV / DM) + EPS); bf16_t* rowp = O + (size_t)r * ldc + col0;
#pragma unroll
                for (int bj = 0; bj < 2; ++bj) { const f32x4 v0 = acc[ai][bj][m][0] * s, v1 = acc[ai][bj][m][1] * s;
                    u32x4 w; w.x = cvt_pk_bf16(v0[0], v0[1]); w.y = cvt_pk_bf16(v0[2], v0[3]); w.z = cvt_pk_bf16(v1[0], v1[1]); w.w = cvt_pk_bf16(v1[2], v1[3]);
                    *(GAS u32x4*)(rowp + bj * HALF) = w; } }
    }
};
struct EpiQ {
    bf16_t* O; const float* rs; const float* cs; const float* sn;
    __device__ __forceinline__ void operator()(const f32x4 (&acc)[2][2][4][2], const Unit& u, int wr, int wc, int fr, int fq) const {
        const int row0 = u.pm * BM + wr * 64 + fr, col0 = u.pn * BM + wc * 32 + 8 * fq;
#pragma unroll
        for (int bj = 0; bj < 2; ++bj) {
            const int cb = u.pn * BM + bj * HALF + wc * 32, d = cb % 192; const bool rope = d >= 128; const int j0 = ((d - 128) >> 1) + 4 * fq;
#pragma unroll
            for (int ai = 0; ai < 2; ++ai)
#pragma unroll
                for (int m = 0; m < 4; ++m) { const int r = row0 + ai * HALF + m * 16; const float s = *(const GAS float*)(rs + r) * 0.10411754831265403f;
                    f32x4 v0 = acc[ai][bj][m][0] * s, v1 = acc[ai][bj][m][1] * s;
                    if (rope) { const f32x4 c4 = *(const GAS f32x4*)(cs + (size_t)r * 32 + j0), s4 = *(const GAS f32x4*)(sn + (size_t)r * 32 + j0);
                        f32x4 a, b; a[0] = v0[0] * c4[0] - v0[1] * s4[0]; a[1] = v0[0] * s4[0] + v0[1] * c4[0]; a[2] = v0[2] * c4[1] - v0[3] * s4[1]; a[3] = v0[2] * s4[1] + v0[3] * c4[1];
                        b[0] = v1[0] * c4[2] - v1[1] * s4[2]; b[1] = v1[0] * s4[2] + v1[1] * c4[2]; b[2] = v1[2] * c4[3] - v1[3] * s4[3]; b[3] = v1[2] * s4[3] + v1[3] * c4[3]; v0 = a; v1 = b; }
                    u32x4 w; w.x = cvt_pk_bf16(v0[0], v0[1]); w.y = cvt_pk_bf16(v0[2], v0[3]); w.z = cvt_pk_bf16(v1[0], v1[1]); w.w = cvt_pk_bf16(v1[2], v1[3]);
                    *(GAS u32x4*)(O + (size_t)r * QW + col0 + bj * HALF) = w; }
        }
    }
};
__device__ __forceinline__ float dpp_f(float oldv, float src, int ctrl_sel) {
    const int o = __float_as_int(oldv), v = __float_as_int(src); int r;
    if (ctrl_sel == 0) r = __builtin_amdgcn_update_dpp(o, v, 0x111, 0xf, 0xf, false);
    else if (ctrl_sel == 1) r = __builtin_amdgcn_update_dpp(o, v, 0x101, 0xf, 0xf, false);
    else if (ctrl_sel == 2) r = __builtin_amdgcn_update_dpp(o, v, 0x121, 0xf, 0xf, false);
    else r = __builtin_amdgcn_update_dpp(o, v, 0x12F, 0xf, 0xf, false);
    return __int_as_float(r);
}
struct EpiGU {
    bf16_t* ACT; bf16_t* SBG; bf16_t* SBU; const float* cw; const float* cb; LAS float* X; const u64_t* ssq;
    __device__ __forceinline__ void operator()(const f32x4 (&acc)[2][2][4][2], const Unit& u, int wr, int wc, int fr_, int fq_) const {
        int fr = fr_, fq = fq_; asm volatile("" : "+v"(fr), "+v"(fq));
        const int colf = u.pn * HALF + wc * 32 + 8 * fq;
        float rs[2][4];
#pragma unroll
        for (int ai = 0; ai < 2; ++ai)
#pragma unroll
            for (int m = 0; m < 4; ++m) rs[ai][m] = rsqrtf((float)*(const GAS u64_t*)(ssq + (size_t)u.pm * BM + ai * HALF + wr * 64 + m * 16 + fr) * (SSQ_INV / DM) + EPS);
#pragma unroll
        for (int ai = 0; ai < 2; ++ai) { const int bidx = 2 * ai + wr; LAS float* xb = X + ((bidx * 4 + wc) * 2) * 32 + fq * 8;
            if (fr == 0) { *(LAS f32x4*)(xb) = acc[ai][0][0][0] * rs[ai][0]; *(LAS f32x4*)(xb + 4) = acc[ai][0][0][1] * rs[ai][0]; }
            if (fr == 15) { *(LAS f32x4*)(xb + 32) = acc[ai][0][3][0] * rs[ai][3]; *(LAS f32x4*)(xb + 36) = acc[ai][0][3][1] * rs[ai][3]; } }
        asm volatile("s_waitcnt lgkmcnt(0)\n\ts_barrier" ::: "memory");
#pragma unroll
        for (int n = 0; n < 2; ++n) {
            const f32x4 w0 = *(const GAS f32x4*)(cw + colf + 4 * n), w1 = *(const GAS f32x4*)(cw + FF + colf + 4 * n), w2 = *(const GAS f32x4*)(cw + 2 * FF + colf + 4 * n), bb = *(const GAS f32x4*)(cb + colf + 4 * n);
#pragma unroll
            for (int ai = 0; ai < 2; ++ai) { const int bidx = 2 * ai + wr;
                f32x4 ep = (f32x4){0.f, 0.f, 0.f, 0.f}, en = (f32x4){0.f, 0.f, 0.f, 0.f};
                if (bidx > 0) ep = *(const LAS f32x4*)(X + (((bidx - 1) * 4 + wc) * 2 + 1) * 32 + fq * 8 + 4 * n);
                if (bidx < 3) en = *(const LAS f32x4*)(X + (((bidx + 1) * 4 + wc) * 2) * 32 + fq * 8 + 4 * n);
                f32x4 gs[4];
#pragma unroll
                for (int m = 0; m < 4; ++m) gs[m] = acc[ai][0][m][n] * rs[ai][m];
#pragma unroll
                for (int m = 0; m < 4; ++m) { const int rt = ai * HALF + wr * 64 + m * 16 + fr; const size_t r = (size_t)u.pm * BM + rt; float ov[4];
#pragma unroll
                    for (int i = 0; i < 4; ++i) { const float g = gs[m][i];
                        const float oldp = (m > 0) ? dpp_f(0.f, gs[m > 0 ? m - 1 : 0][i], 2) : ep[i];
                        const float gp = dpp_f(oldp, g, 0);
                        const float oldn = (m < 3) ? dpp_f(0.f, gs[m < 3 ? m + 1 : 3][i], 3) : en[i];
                        const float gn = dpp_f(oldn, g, 1);
                        const float c = w0[i] * gp + w1[i] * g + w2[i] * gn + bb[i];
                        ov[i] = c * __builtin_amdgcn_rcpf(1.f + __expf(-c)) * (acc[ai][1][m][n][i] * rs[ai][m]); }
                    u32x2 wv; wv.x = cvt_pk_bf16(ov[0], ov[1]); wv.y = cvt_pk_bf16(ov[2], ov[3]);
                    *(GAS u32x2*)(ACT + r * FF + colf + 4 * n) = wv;
                    if (rt < 2 || rt >= 254) {
                        const int si = rt < 2 ? rt : rt - 252; const f32x4 g0 = gs[m]; u32x2 gw; gw.x = cvt_pk_bf16(g0[0], g0[1]); gw.y = cvt_pk_bf16(g0[2], g0[3]);
                        *(GAS u32x2*)(SBG + ((size_t)u.pm * 4 + si) * FF + colf + 4 * n) = gw;
                        if (rt == 0 || rt == 255) { const f32x4 u0 = acc[ai][1][m][n] * rs[ai][m]; u32x2 uw; uw.x = cvt_pk_bf16(u0[0], u0[1]); uw.y = cvt_pk_bf16(u0[2], u0[3]);
                            *(GAS u32x2*)(SBU + ((size_t)u.pm * 2 + (rt ? 1 : 0)) * FF + colf + 4 * n) = uw; } } }
            }
        }
    }
};
__device__ __forceinline__ void ssq_commit(u64_t* ssq, float (&q)[2][4], int row0, int fr, int fq) {
    const int lane = fq * 16 + fr;
#pragma unroll
    for (int ai = 0; ai < 2; ++ai)
#pragma unroll
        for (int m = 0; m < 4; ++m) { float v = q[ai][m];
            v += __int_as_float(__builtin_amdgcn_ds_bpermute((lane ^ 16) << 2, __float_as_int(v)));
            v += __int_as_float(__builtin_amdgcn_ds_bpermute((lane ^ 32) << 2, __float_as_int(v)));
            if (fq == 0) __hip_atomic_fetch_add(ssq + row0 + ai * HALF + m * 16, (u64_t)(v * SSQ_FX + 0.5f), __ATOMIC_RELAXED, __HIP_MEMORY_SCOPE_AGENT); }
}
struct EpiRes {
    const float* base; const bf16_t* baseb; float* out; bf16_t* xb; u64_t* ssq;
    __device__ __forceinline__ void operator()(const f32x4 (&acc)[2][2][4][2], const Unit& u, int wr, int wc, int fr, int fq) const {
        const int row0 = u.pm * BM + wr * 64 + fr, col0 = u.pn * BM + wc * 32 + 8 * fq;
        float q[2][4];
#pragma unroll
        for (int ai = 0; ai < 2; ++ai)
#pragma unroll
            for (int m = 0; m < 4; ++m) { const size_t off = (size_t)(row0 + ai * HALF + m * 16) * DM + col0; q[ai][m] = 0.f;
#pragma unroll
                for (int bj = 0; bj < 2; ++bj) { f32x4 b0, b1;
                    if (baseb) { const u32x4 bw = *(const GAS u32x4*)(baseb + off + bj * HALF); b0 = (f32x4){bf_lo(bw.x), bf_hi(bw.x), bf_lo(bw.y), bf_hi(bw.y)}; b1 = (f32x4){bf_lo(bw.z), bf_hi(bw.z), bf_lo(bw.w), bf_hi(bw.w)}; }
                    else { b0 = *(const GAS f32x4*)(base + off + bj * HALF); b1 = *(const GAS f32x4*)(base + off + bj * HALF + 4); }
                    const f32x4 o0 = b0 + acc[ai][bj][m][0], o1 = b1 + acc[ai][bj][m][1];
                    if (out) { *(GAS f32x4*)(out + off + bj * HALF) = o0; *(GAS f32x4*)(out + off + bj * HALF + 4) = o1; }
                    q[ai][m] += (o0[0] * o0[0] + o0[1] * o0[1]) + (o0[2] * o0[2] + o0[3] * o0[3]) + (o1[0] * o1[0] + o1[1] * o1[1]) + (o1[2] * o1[2] + o1[3] * o1[3]);
                    if (xb) { u32x4 w; w.x = cvt_pk_bf16(o0[0], o0[1]); w.y = cvt_pk_bf16(o0[2], o0[3]); w.z = cvt_pk_bf16(o1[0], o1[1]); w.w = cvt_pk_bf16(o1[2], o1[3]); *(GAS u32x4*)(xb + off + bj * HALF) = w; } } }
        if (ssq) ssq_commit(ssq, q, row0, fr, fq);
    }
};
struct EpiPle {
    const bf16_t* baseb; float* out; const float* bias; const bf16_t* pp; bf16_t* xb; u64_t* ssq;
    __device__ __forceinline__ void operator()(const f32x4 (&acc)[2][2][4][2], const Unit& u, int wr, int wc, int fr, int fq) const {
        const int row0 = u.pm * BM + wr * 64 + fr, col0 = u.pn * BM + wc * 32 + 8 * fq;
        f32x4 bv[2][2]; float q[2][4];
#pragma unroll
        for (int bj = 0; bj < 2; ++bj) { bv[bj][0] = *(const GAS f32x4*)(bias + col0 + bj * HALF); bv[bj][1] = *(const GAS f32x4*)(bias + col0 + bj * HALF + 4); }
#pragma unroll
        for (int ai = 0; ai < 2; ++ai)
#pragma unroll
            for (int m = 0; m < 4; ++m) { const size_t off = (size_t)(row0 + ai * HALF + m * 16) * DM + col0; q[ai][m] = 0.f;
#pragma unroll
                for (int bj = 0; bj < 2; ++bj) { const u32x4 bw = *(const GAS u32x4*)(baseb + off + bj * HALF);
                    const f32x4 b0 = {bf_lo(bw.x), bf_hi(bw.x), bf_lo(bw.y), bf_hi(bw.y)}, b1 = {bf_lo(bw.z), bf_hi(bw.z), bf_lo(bw.w), bf_hi(bw.w)};
                    const u32x4 pw = *(const GAS u32x4*)(pp + off + bj * HALF);
                    const f32x4 p0 = {bf_lo(pw.x), bf_hi(pw.x), bf_lo(pw.y), bf_hi(pw.y)}, p1 = {bf_lo(pw.z), bf_hi(pw.z), bf_lo(pw.w), bf_hi(pw.w)};
                    const f32x4 z0 = acc[ai][bj][m][0] + bv[bj][0], z1 = acc[ai][bj][m][1] + bv[bj][1]; f32x4 g0, g1;
#pragma unroll
                    for (int i = 0; i < 4; ++i) { g0[i] = __builtin_amdgcn_rcpf(1.f + __expf(-z0[i])); g1[i] = __builtin_amdgcn_rcpf(1.f + __expf(-z1[i])); }
                    const f32x4 o0 = b0 + g0 * p0, o1 = b1 + g1 * p1;
                    if (out) { *(GAS f32x4*)(out + off + bj * HALF) = o0; *(GAS f32x4*)(out + off + bj * HALF + 4) = o1; }
                    if (xb) { q[ai][m] += (o0[0] * o0[0] + o0[1] * o0[1]) + (o0[2] * o0[2] + o0[3] * o0[3]) + (o1[0] * o1[0] + o1[1] * o1[1]) + (o1[2] * o1[2] + o1[3] * o1[3]);
                        u32x4 w; w.x = cvt_pk_bf16(o0[0], o0[1]); w.y = cvt_pk_bf16(o0[2], o0[3]); w.z = cvt_pk_bf16(o1[0], o1[1]); w.w = cvt_pk_bf16(o1[2], o1[3]); *(GAS u32x4*)(xb + off + bj * HALF) = w; } } }
        if (xb) ssq_commit(ssq, q, row0, fr, fq);
    }
};

template <class Epi, bool ALIGN_EPI>
__device__ __forceinline__ void gemm_phase(LAS unsigned char* lds, const Gemm g, const StaticOrder& S, const Epi& E, const int wave_s) {
    int tid_ = tid_now(wave_s); asm volatile("" : "+v"(tid_));
    const int tid = tid_, wid = __builtin_amdgcn_readfirstlane(tid >> 6), lane = tid & 63, wr = wid >> 2, wc = wid & 3, fr = lane & 15, fq = lane >> 4;
    int K_ = g.K, lda_ = g.lda; asm volatile("" : "+s"(K_), "+s"(lda_));
    const int K = K_, nt = K / BK, lda = lda_;
    unsigned voffA[2], voffB[2];
#pragma unroll
    for (int i = 0; i < 2; ++i) { int R, C; stage_rc(tid * 16 + i * 8192, R, C); const int Rb = (R & ~31) + perm32(R & 31);
        voffA[i] = (unsigned)(R * lda + C) * 2u; voffB[i] = (unsigned)(Rb * K + C) * 2u; }
    const size_t kstep = (size_t)(BK * 2);
    const size_t hstepA = (size_t)HALF * lda * 2, hstepB = (size_t)HALF * K * 2;
    const size_t tstepA = 2 * hstepA, tstepB = 2 * hstepB;
    const unsigned ldsw = (unsigned)wid * 1024u;
    const int aoff = lds_byte(wr * 64 + fr, fq * 8), boff = lds_byte(wc * 32 + fr, fq * 8);
#define PG8_SA(b, h) (((b) * 2 + (h)) * HTB)
#define PG8_SB(b, h) ((4 + (b) * 2 + (h)) * HTB)
#define PG8_STAGE(bufoff, gbase, voff) do { _Pragma("unroll") for (int _i = 0; _i < 2; ++_i) \
        __builtin_amdgcn_global_load_lds((const unsigned*)((const char*)(gbase) + (voff)[_i]), (LAS unsigned*)(lds + (bufoff) + ldsw + _i * 8192), 16, 0, 0); } while (0)
#define PG8_LDA(dst, b, h) do { _Pragma("unroll") for (int m = 0; m < 4; ++m) _Pragma("unroll") for (int k = 0; k < 2; ++k) dst[m][k] = *(const LAS bf16x8*)(lds + PG8_SA(b, h) + aoff + m * 2048 + k * 1024); } while (0)
#define PG8_LDB(dst, b, h) do { _Pragma("unroll") for (int n = 0; n < 2; ++n) _Pragma("unroll") for (int k = 0; k < 2; ++k) dst[n][k] = *(const LAS bf16x8*)(lds + PG8_SB(b, h) + boff + n * 2048 + k * 1024); } while (0)
#define PG8_MMA(ai, bj, At, Bt) do { __builtin_amdgcn_s_setprio(1); _Pragma("unroll") for (int m = 0; m < 4; ++m) _Pragma("unroll") for (int n = 0; n < 2; ++n) _Pragma("unroll") for (int k = 0; k < 2; ++k) \
        acc[ai][bj][m][n] = __builtin_amdgcn_mfma_f32_16x16x32_bf16(Bt[n][k], At[m][k], acc[ai][bj][m][n], 0, 0, 0); __builtin_amdgcn_s_setprio(0); } while (0)
#define PG8_WAIT_V(n) asm volatile("s_waitcnt vmcnt(" #n ")" ::: "memory")
#define PG8_WAIT_L(n) asm volatile("s_waitcnt lgkmcnt(" #n ")" ::: "memory")
#define PG8_BAR __builtin_amdgcn_s_barrier()
#define PG8_SCHED __builtin_amdgcn_sched_barrier(0)
    Unit cur, nxt; int ui = 0;
    if (!S.next(0, cur)) return;
    f32x4 acc[2][2][4][2];
    float zz0; asm volatile("v_mov_b32 %0, 0" : "=v"(zz0));
#pragma unroll
    for (int a = 0; a < 2; ++a)
#pragma unroll
        for (int b = 0; b < 2; ++b)
#pragma unroll
            for (int m = 0; m < 4; ++m)
#pragma unroll
                for (int n = 0; n < 2; ++n) acc[a][b][m][n] = (f32x4){zz0, zz0, zz0, zz0};
    bf16x8 At[4][2], B0[2][2], B1[2][2];
    const char* cA = (const char*)g.A + (size_t)cur.pm * tstepA; const char* cB = (const char*)g.Bt + (size_t)cur.pn * tstepB;
    PG8_STAGE(PG8_SB(0, 0), cB, voffB); PG8_STAGE(PG8_SB(0, 1), cB + hstepB, voffB); PG8_STAGE(PG8_SA(0, 0), cA, voffA); PG8_STAGE(PG8_SA(0, 1), cA + hstepA, voffA);
    if (wr == 1) PG8_BAR;
    PG8_WAIT_V(2); PG8_BAR;
    PG8_STAGE(PG8_SB(1, 0), cB + kstep, voffB); PG8_STAGE(PG8_SA(1, 0), cA + kstep, voffA); PG8_STAGE(PG8_SB(1, 1), cB + hstepB + kstep, voffB);
    PG8_WAIT_V(6); PG8_BAR;
    for (;;) {
        const bool has_next = S.next(ui + 1, nxt);
        const char* nA = has_next ? (const char*)g.A + (size_t)nxt.pm * tstepA : cA; const char* nB = has_next ? (const char*)g.Bt + (size_t)nxt.pn * tstepB : cB;
        for (int t = 0; t < nt; t += 2) {
            const bool last = (t == nt - 2);
            const char* a1 = cA + (size_t)(t + 1) * kstep;
            const char* a2 = last ? nA : cA + (size_t)(t + 2) * kstep; const char* b2 = last ? nB : cB + (size_t)(t + 2) * kstep;
            const char* a3 = a2 + kstep; const char* b3 = b2 + kstep;
            PG8_LDB(B0, 0, 0); PG8_LDB(B1, 0, 1); PG8_SCHED; PG8_LDA(At, 0, 0); PG8_STAGE(PG8_SA(1, 1), a1 + hstepA, voffA);
            PG8_WAIT_V(8); PG8_WAIT_L(0); PG8_BAR; PG8_MMA(0, 0, At, B0); PG8_MMA(0, 1, At, B1); PG8_BAR; PG8_SCHED;
            PG8_LDA(At, 0, 1); PG8_STAGE(PG8_SB(0, 0), b2, voffB); PG8_STAGE(PG8_SB(0, 1), b2 + hstepB, voffB); PG8_STAGE(PG8_SA(0, 0), a2, voffA);
            PG8_WAIT_V(8); PG8_WAIT_L(0); PG8_BAR; PG8_MMA(1, 0, At, B0); PG8_MMA(1, 1, At, B1); PG8_BAR; PG8_SCHED;
            PG8_LDB(B0, 1, 0); PG8_LDB(B1, 1, 1); PG8_SCHED; PG8_LDA(At, 1, 0); PG8_STAGE(PG8_SA(0, 1), a2 + hstepA, voffA);
            PG8_WAIT_V(8); PG8_WAIT_L(0); PG8_BAR; PG8_MMA(0, 0, At, B0); PG8_MMA(0, 1, At, B1); PG8_BAR; PG8_SCHED;
            PG8_LDA(At, 1, 1); PG8_STAGE(PG8_SB(1, 0), b3, voffB); PG8_STAGE(PG8_SB(1, 1), b3 + hstepB, voffB); PG8_STAGE(PG8_SA(1, 0), a3, voffA);
            PG8_WAIT_V(8); PG8_WAIT_L(0); PG8_BAR; PG8_MMA(1, 0, At, B0); PG8_MMA(1, 1, At, B1); PG8_BAR; PG8_SCHED;
        }
        if constexpr (ALIGN_EPI) { if (wr == 0) PG8_BAR; }
        E(acc, cur, wr, wc, fr, fq);
        if (!has_next) break;
        float zz1; asm volatile("v_mov_b32 %0, 0" : "=v"(zz1));
#pragma unroll
        for (int a = 0; a < 2; ++a)
#pragma unroll
            for (int b = 0; b < 2; ++b)
#pragma unroll
                for (int m = 0; m < 4; ++m)
#pragma unroll
                    for (int n = 0; n < 2; ++n) acc[a][b][m][n] = (f32x4){zz1, zz1, zz1, zz1};
        cur = nxt; cA = nA; cB = nB; ++ui;
        if constexpr (ALIGN_EPI) { if (wr == 1) PG8_BAR; }
    }
    PG8_WAIT_V(0);
    if constexpr (!ALIGN_EPI) { if (wr == 0) PG8_BAR; }
    PG8_BAR;
#undef PG8_SA
#undef PG8_SB
#undef PG8_STAGE
#undef PG8_LDA
#undef PG8_LDB
#undef PG8_MMA
#undef PG8_WAIT_V
#undef PG8_WAIT_L
#undef PG8_BAR
#undef PG8_SCHED
}
}

namespace att {
constexpr int QBLK = 32, KVBLK = 64;
constexpr int SHM_V = 16384, SHM_K = 16384, SHM_KR = 8192;
constexpr int OFF_K = 0, OFF_KRL = OFF_K + 3 * SHM_K, OFF_V = OFF_KRL + 3 * SHM_KR, OFF_WSF = OFF_V + 3 * SHM_V, OFF_BT = OFF_WSF + 8 * 64 * 4, LDS_END = OFF_BT + 4 * 768 * 4;
constexpr float THR = 8.f, LOG2E = 1.4426950408889634f;
constexpr float SC_MLA = 0.07216878364870322f  , SC_SWA = 0.08838834764831845f  ;
#define KSWZ(row, colB) ((row) * 256 + ((colB) ^ (((row) & 7) << 4)))
#define KRSWZ(row, colB) ((row) * 128 + ((colB) ^ (((row) & 7) << 4)))
#define SBAR() __builtin_amdgcn_sched_barrier(0)
__device__ __forceinline__ int crow(int r, int hi) { return (r & 3) + 8 * (r >> 2) + 4 * hi; }

template <bool MLA>
__device__ __forceinline__ void partialSM(f32x16& p0, f32x16& p1, float& m_reg, float& mn, float& alpha) {
    constexpr float SCL = MLA ? SC_MLA : 1.f, C = SCL * LOG2E;
    float pmax = p0[0];
#pragma unroll
    for (int r = 1; r < 16; ++r) pmax = fmaxf(pmax, p0[r]);
#pragma unroll
    for (int r = 0; r < 16; ++r) pmax = fmaxf(pmax, p1[r]);
    { auto rr = __builtin_amdgcn_permlane32_swap(__float_as_uint(pmax), __float_as_uint(pmax), false, false);
      pmax = fmaxf(__uint_as_float(rr[0]), __uint_as_float(rr[1])); }
    if (__builtin_expect(__all(pmax - m_reg <= THR / SCL), 1)) { mn = m_reg; alpha = 1.f; }
    else { mn = fmaxf(m_reg, pmax); alpha = __builtin_amdgcn_exp2f((m_reg - mn) * C); m_reg = mn; }
    const float mnC = -mn * C;
#pragma unroll
    for (int r = 0; r < 16; ++r) p0[r] = fmaf(p0[r], C, mnC);
#pragma unroll
    for (int r = 0; r < 16; ++r) p1[r] = fmaf(p1[r], C, mnC);
#pragma unroll
    for (int r = 0; r < 16; ++r) p0[r] = __builtin_amdgcn_exp2f(p0[r]);
}
template <bool FIRST>
__device__ __forceinline__ void partialSM_mla(f32x16& p0, f32x16& p1, float& m_reg, f32x16& negm, float& alpha) {
    constexpr float THRL = THR * LOG2E;
    float pmax = p0[0];
#pragma unroll
    for (int r = 1; r < 16; ++r) pmax = fmaxf(pmax, p0[r]);
#pragma unroll
    for (int r = 0; r < 16; ++r) pmax = fmaxf(pmax, p1[r]);
    { auto rr = __builtin_amdgcn_permlane32_swap(__float_as_uint(pmax), __float_as_uint(pmax), false, false);
      pmax = fmaxf(__uint_as_float(rr[0]), __uint_as_float(rr[1])); }
    if (!FIRST && __builtin_expect(__all(pmax <= THRL), 1)) { alpha = 1.f; }
    else { const float dl = FIRST ? pmax : fmaxf(pmax, 0.f); m_reg += dl; alpha = FIRST ? 1.f : __builtin_amdgcn_exp2f(-dl);
#pragma unroll
        for (int r = 0; r < 16; ++r) { p0[r] -= dl; p1[r] -= dl; }
#pragma unroll
        for (int r = 0; r < 16; ++r) negm[r] = -m_reg;
        asm volatile("" : "+v"(negm)); }
#pragma unroll
    for (int r = 0; r < 16; ++r) p0[r] = __builtin_amdgcn_exp2f(p0[r]);
}
__device__ __forceinline__ void finishSM(f32x16& p0, f32x16& p1, float alpha, float& l_reg, bf16x8& pa0, bf16x8& pa1, bf16x8& pa2, bf16x8& pa3) {
#pragma unroll
    for (int r = 0; r < 16; ++r) p1[r] = __builtin_amdgcn_exp2f(p1[r]);
    float ps = 0;
#pragma unroll
    for (int r = 0; r < 16; ++r) ps += p0[r];
#pragma unroll
    for (int r = 0; r < 16; ++r) ps += p1[r];
    { auto rr = __builtin_amdgcn_permlane32_swap(__float_as_uint(ps), __float_as_uint(ps), false, false);
      ps = __uint_as_float(rr[0]) + __uint_as_float(rr[1]); }
    l_reg = l_reg * alpha + ps;
#define PK4(P, BASE, OUT) do { unsigned a0 = cvt_pk_bf16(P[BASE + 0], P[BASE + 1]), a1 = cvt_pk_bf16(P[BASE + 2], P[BASE + 3]);   \
    unsigned b0 = cvt_pk_bf16(P[BASE + 4], P[BASE + 5]), b1 = cvt_pk_bf16(P[BASE + 6], P[BASE + 7]);                              \
    auto r0 = __builtin_amdgcn_permlane32_swap(a0, b0, false, false); auto r1 = __builtin_amdgcn_permlane32_swap(a1, b1, false, false); \
    u32x4 w = {r0[0], r1[0], r0[1], r1[1]}; OUT = *reinterpret_cast<bf16x8*>(&w); } while (0)
    PK4(p0, 0, pa0); PK4(p0, 8, pa1); PK4(p1, 0, pa2); PK4(p1, 8, pa3);
#undef PK4
}
template <bool MLA>
__device__ __forceinline__ void qkt(f32x16& p0, f32x16& p1, const char* Ks, const char* Krs, const bf16x8* qr, int r32, int hi, const f32x16& cinit) {
    p0 = cinit; p1 = cinit;
#pragma unroll
    for (int d0 = 0; d0 < 8; ++d0) { const int cb = (d0 * 16 + hi * 8) * 2;
        const bf16x8 b0 = *reinterpret_cast<const bf16x8*>(Ks + KSWZ(r32, cb));
        const bf16x8 b1 = *reinterpret_cast<const bf16x8*>(Ks + KSWZ(32 + r32, cb));
        p0 = __builtin_amdgcn_mfma_f32_32x32x16_bf16(b0, qr[d0], p0, 0, 0, 0);
        p1 = __builtin_amdgcn_mfma_f32_32x32x16_bf16(b1, qr[d0], p1, 0, 0, 0); }
    if constexpr (MLA) {
#pragma unroll
        for (int d0 = 0; d0 < 4; ++d0) { const int cb = (d0 * 16 + hi * 8) * 2;
            const bf16x8 b0 = *reinterpret_cast<const bf16x8*>(Krs + KRSWZ(r32, cb));
            const bf16x8 b1 = *reinterpret_cast<const bf16x8*>(Krs + KRSWZ(32 + r32, cb));
            p0 = __builtin_amdgcn_mfma_f32_32x32x16_bf16(b0, qr[8 + d0], p0, 0, 0, 0);
            p1 = __builtin_amdgcn_mfma_f32_32x32x16_bf16(b1, qr[8 + d0], p1, 0, 0, 0); }
    }
}
#define PK4(P, BASE, OUT) do { unsigned a0 = cvt_pk_bf16(P[BASE + 0], P[BASE + 1]), a1 = cvt_pk_bf16(P[BASE + 2], P[BASE + 3]);   \
    unsigned b0_ = cvt_pk_bf16(P[BASE + 4], P[BASE + 5]), b1_ = cvt_pk_bf16(P[BASE + 6], P[BASE + 7]);                              \
    auto r0 = __builtin_amdgcn_permlane32_swap(a0, b0_, false, false); auto r1 = __builtin_amdgcn_permlane32_swap(a1, b1_, false, false); \
    u32x4 w = {r0[0], r1[0], r0[1], r1[1]}; OUT = *reinterpret_cast<bf16x8*>(&w); } while (0)
#define LFIN() do { auto rr = __builtin_amdgcn_permlane32_swap(__float_as_uint(ps), __float_as_uint(ps), false, false); \
    ps = __uint_as_float(rr[0]) + __uint_as_float(rr[1]); l_reg = l_reg * alpha + ps; } while (0)
__device__ __forceinline__ void pack_p0(const f32x16& p0, bf16x8& pa0, bf16x8& pa1, float& ps0) {
    float a = 0.f;
#pragma unroll
    for (int r = 0; r < 16; ++r) a += p0[r];
    ps0 = a; PK4(p0, 0, pa0); PK4(p0, 8, pa1);
}
__device__ __forceinline__ void fin_p1(f32x16& p1, float alpha, float& l_reg, float ps0, bf16x8& pa2, bf16x8& pa3) {
    float ps = ps0;
#pragma unroll
    for (int r = 0; r < 16; ++r) { p1[r] = __builtin_amdgcn_exp2f(p1[r]); ps += p1[r]; }
    LFIN(); PK4(p1, 0, pa2); PK4(p1, 8, pa3);
}
template <bool MLA>
__device__ __forceinline__ void qkt_fin(f32x16& n0, f32x16& n1, const char* Ks, const char* Krs, const bf16x8* qr, int r32, int hi, const f32x16& cinit,
                                        f32x16& p1, float alpha, float& l_reg, float ps0, bf16x8& pa2, bf16x8& pa3) {
    constexpr int NSTEP = MLA ? 12 : 8;
    float ps = ps0;
#pragma unroll
    for (int s_ = 0; s_ < NSTEP; ++s_) {
        const bool rope = s_ >= 8; const int d0 = rope ? s_ - 8 : s_; const int cb = (d0 * 16 + hi * 8) * 2;
        const bf16x8 b0 = rope ? *reinterpret_cast<const bf16x8*>(Krs + KRSWZ(r32, cb)) : *reinterpret_cast<const bf16x8*>(Ks + KSWZ(r32, cb));
        const bf16x8 b1 = rope ? *reinterpret_cast<const bf16x8*>(Krs + KRSWZ(32 + r32, cb)) : *reinterpret_cast<const bf16x8*>(Ks + KSWZ(32 + r32, cb));
        if (s_ == 0) { n0 = __builtin_amdgcn_mfma_f32_32x32x16_bf16(b0, qr[0], cinit, 0, 0, 0); n1 = __builtin_amdgcn_mfma_f32_32x32x16_bf16(b1, qr[0], cinit, 0, 0, 0); }
        else { n0 = __builtin_amdgcn_mfma_f32_32x32x16_bf16(b0, qr[s_], n0, 0, 0, 0); n1 = __builtin_amdgcn_mfma_f32_32x32x16_bf16(b1, qr[s_], n1, 0, 0, 0); }
        if (s_ < 8) { p1[2 * s_] = __builtin_amdgcn_exp2f(p1[2 * s_]); p1[2 * s_ + 1] = __builtin_amdgcn_exp2f(p1[2 * s_ + 1]); ps += p1[2 * s_] + p1[2 * s_ + 1]; }
        if (s_ == 4) PK4(p1, 0, pa2);
        if (MLA && s_ == 8) { LFIN(); PK4(p1, 8, pa3); }
        SBAR();
    }
    if (!MLA) { LFIN(); PK4(p1, 8, pa3); }
}
#undef PK4
#undef LFIN
__device__ __forceinline__ int v_st(int k, int c) { const int kk = (k & ~0xC) | ((k & 4) << 1) | ((k & 8) >> 1); return ((kk >> 3) * 4 + (c >> 5)) * 512 + ((kk & 7) * 32 + (c & 31)) * 2; }
__device__ __forceinline__ int v_rd_base(int lane) { return ((lane & 3) << 3) | (((lane >> 2) & 3) << 6) | (((lane >> 4) & 1) << 5) | (((lane >> 5) & 1) << 8); }
constexpr int v_rd_off(int d0, int ks, int half) { return d0 * 512 + ks * 4096 + half * 2048; }
template <int OFF> __device__ __forceinline__ s16x4 tr_read(int vb) {
    s16x4 r; asm volatile("ds_read_b64_tr_b16 %0, %1 offset:%2" : "=&v"(r) : "v"(vb), "i"(OFF) : "memory"); return r;
}
template <int KS> __device__ __forceinline__ void pv_ks(f32x16* o, int vb, bf16x8 pa) {
    const s16x4 l0 = tr_read<v_rd_off(0, KS, 0)>(vb), h0 = tr_read<v_rd_off(0, KS, 1)>(vb), l1 = tr_read<v_rd_off(1, KS, 0)>(vb), h1 = tr_read<v_rd_off(1, KS, 1)>(vb);
    const s16x4 l2 = tr_read<v_rd_off(2, KS, 0)>(vb), h2 = tr_read<v_rd_off(2, KS, 1)>(vb), l3 = tr_read<v_rd_off(3, KS, 0)>(vb), h3 = tr_read<v_rd_off(3, KS, 1)>(vb);
    asm volatile("s_waitcnt lgkmcnt(0)" ::: "memory"); SBAR();
#define PK(L, H) (bf16x8){L[0], L[1], L[2], L[3], H[0], H[1], H[2], H[3]}
    o[0] = __builtin_amdgcn_mfma_f32_32x32x16_bf16(pa, PK(l0, h0), o[0], 0, 0, 0);
    o[1] = __builtin_amdgcn_mfma_f32_32x32x16_bf16(pa, PK(l1, h1), o[1], 0, 0, 0);
    o[2] = __builtin_amdgcn_mfma_f32_32x32x16_bf16(pa, PK(l2, h2), o[2], 0, 0, 0);
    o[3] = __builtin_amdgcn_mfma_f32_32x32x16_bf16(pa, PK(l3, h3), o[3], 0, 0, 0);
#undef PK
}
__device__ __forceinline__ void pv_d0(f32x16* o, int vb, bf16x8 pa0, bf16x8 pa1, bf16x8 pa2, bf16x8 pa3) {
    pv_ks<0>(o, vb, pa0); pv_ks<1>(o, vb, pa1); pv_ks<2>(o, vb, pa2); pv_ks<3>(o, vb, pa3);
}
__device__ __forceinline__ void swa_fix(f32x16& p0, f32x16& p1, const float* bt, int relb, int hi) {
    const float* bp = bt + (relb + 384 + 4 * hi);
#pragma unroll
    for (int r = 0; r < 16; ++r) { const int c = (r & 3) + 8 * (r >> 2); p0[r] = fmaf(p0[r], SC_SWA, bp[c]); p1[r] = fmaf(p1[r], SC_SWA, bp[c + 32]); }
}

template <bool MLA, int ldq, int ldk, int ldo, bool GQA4 = false>
__device__ __forceinline__ void attn_unit(const bf16_t* Qb, const bf16_t* Kh, const bf16_t* Vh, const bf16_t* Krh,
                                          bf16_t* Ob, const int NT, char* lds, const int rel0, const float sink, const int wave_s) {
    constexpr int NQ = MLA ? 12 : 8;
    int tid_ = tid_now(wave_s); asm volatile("" : "+v"(tid_));
    const int tid = tid_, wid = tid >> 6, lane = tid & 63, r32 = lane & 31, hi = lane >> 5;
    const int widu = __builtin_amdgcn_readfirstlane(wid);
    LAS unsigned char* ldsl = (LAS unsigned char*)lds;
    char* V_lds = lds + OFF_V; char* K_lds = lds + OFF_K; char* Kr_lds = lds + OFF_KRL;
    float* ws = (float*)(lds + OFF_WSF) + wid * 64; float* li_l = ws; float* al_l = ws + 32;
    const float* bt = (const float*)(lds + OFF_BT) + (GQA4 ? (wid >> 1) * 768 : 0);
    float m_reg = MLA ? -1e30f : sink, l_reg = MLA ? 0.f : 1.f; f32x16 o[4] = {}; bf16x8 qr[NQ];
    const bf16_t* Qw = GQA4 ? Qb + (long)((wid & 1) * QBLK + r32) * ldq + (wid >> 1) * 128 + hi * 8 : Qb + (long)(wid * QBLK + r32) * ldq + hi * 8;
#pragma unroll
    for (int d0 = 0; d0 < NQ; ++d0) qr[d0] = *(const GAS bf16x8*)(Qw + d0 * 16);
    int koff, voff, kroff;
    { const int b = wid * 1024 + lane * 16;
      { const int row = b >> 8, cB = (b & 255) ^ ((row & 7) << 4); koff = row * ldk + (cB >> 1); }
      { const int sub = b >> 9, kk = (sub >> 2) * 8 + ((b & 511) >> 6), c = (sub & 3) * 32 + ((b & 63) >> 1), k = (kk & ~0xC) | ((kk & 4) << 1) | ((kk & 8) >> 1); voff = k * ldk + c; }
      { const int row = b >> 7, cB = (b & 127) ^ ((row & 7) << 4); kroff = row * ROPE + (cB >> 1); } }
    const int vb0 = (int)(uintptr_t)V_lds + v_rd_base(lane);
    const int relq = rel0 - (GQA4 ? (wid & 1) : wid) * QBLK - r32;
#define DMA_K(t, s) do { const bf16_t* kp_ = Kh + (long)(t) * KVBLK * ldk; \
    __builtin_amdgcn_global_load_lds((const unsigned*)(kp_ + koff), (LAS unsigned*)(ldsl + OFF_K + (s) * SHM_K + widu * 1024), 16, 0, 0); \
    __builtin_amdgcn_global_load_lds((const unsigned*)(kp_ + 32 * ldk + koff), (LAS unsigned*)(ldsl + OFF_K + (s) * SHM_K + 8192 + widu * 1024), 16, 0, 0); \
    if constexpr (MLA) __builtin_amdgcn_global_load_lds((const unsigned*)(Krh + (long)(t) * KVBLK * ROPE + kroff), (LAS unsigned*)(ldsl + OFF_KRL + (s) * SHM_KR + widu * 1024), 16, 0, 0); } while (0)
#define DMA_V(t, s) do { const bf16_t* vp_ = Vh + (long)(t) * KVBLK * ldk; \
    __builtin_amdgcn_global_load_lds((const unsigned*)(vp_ + voff), (LAS unsigned*)(ldsl + OFF_V + (s) * SHM_V + widu * 1024), 16, 0, 0); \
    __builtin_amdgcn_global_load_lds((const unsigned*)(vp_ + 32 * ldk + voff), (LAS unsigned*)(ldsl + OFF_V + (s) * SHM_V + 8192 + widu * 1024), 16, 0, 0); } while (0)
#define WAITBAR_FULL() asm volatile("s_waitcnt vmcnt(0) lgkmcnt(0)\n\ts_barrier" ::: "memory")
#define WAITBAR_G1() do { if constexpr (MLA) asm volatile("s_waitcnt vmcnt(5) lgkmcnt(0)\n\ts_barrier" ::: "memory"); else asm volatile("s_waitcnt vmcnt(4) lgkmcnt(0)\n\ts_barrier" ::: "memory"); } while (0)
#define WAITBAR_G2() do { if constexpr (MLA) asm volatile("s_waitcnt vmcnt(10) lgkmcnt(0)\n\ts_barrier" ::: "memory"); else asm volatile("s_waitcnt vmcnt(8) lgkmcnt(0)\n\ts_barrier" ::: "memory"); } while (0)
#define RESC(a) do { if (__any((a) < 1.f)) { if (hi == 0) al_l[r32] = (a); asm volatile("s_waitcnt lgkmcnt(0)" ::: "memory"); \
    _Pragma("unroll") for (int d = 0; d < 4; ++d) _Pragma("unroll") for (int r = 0; r < 16; ++r) o[d][r] *= al_l[crow(r, hi)]; } } while (0)
#define FIX(P0, P1, t) do { if constexpr (!MLA) swa_fix(P0, P1, bt, relq + (t) * KVBLK, hi); } while (0)
#define ROT() do { sp = sc; sc = sn; sn = (sn == 2) ? 0 : sn + 1; } while (0)
    f32x16 pA0, pA1, pB0, pB1; float mnA, mnB, alA, alB, ps0; bf16x8 pa0, pa1, pa2, pa3;
    f32x16 negm = f32x16{}; if constexpr (MLA) { m_reg = 0.f; asm volatile("" : "+v"(negm)); }
#define PSM(P0, P1, MN, AL, FIRST) do { if constexpr (MLA) partialSM_mla<FIRST>(P0, P1, m_reg, negm, AL); else partialSM<false>(P0, P1, m_reg, MN, AL); pack_p0(P0, pa0, pa1, ps0); } while (0)
    int sp = 2, sc = 0, sn = 1;
    DMA_K(0, 0); DMA_K(1, 1); DMA_V(0, 0); DMA_K(2, 2); DMA_V(1, 1);
    WAITBAR_G2();
    qkt<MLA>(pA0, pA1, K_lds, Kr_lds, qr, r32, hi, negm); FIX(pA0, pA1, 0); PSM(pA0, pA1, mnA, alA, true);
    WAITBAR_G1();
    DMA_K(3, 0); DMA_V(2, 2);
    ROT();
    for (int j = 1; j + 1 < NT; j += 2) {
        SBAR(); qkt_fin<MLA>(pB0, pB1, K_lds + sc * SHM_K, Kr_lds + sc * SHM_KR, qr, r32, hi, negm, pA1, alA, l_reg, ps0, pa2, pa3); FIX(pB0, pB1, j); SBAR();
        pv_d0(o, vb0 + sp * SHM_V, pa0, pa1, pa2, pa3); PSM(pB0, pB1, mnB, alB, false);
        RESC(alB);
        WAITBAR_G1();
        if (j + 3 < NT) DMA_K(j + 3, sc); DMA_V(j + 2, sp);
        ROT();
        SBAR(); qkt_fin<MLA>(pA0, pA1, K_lds + sc * SHM_K, Kr_lds + sc * SHM_KR, qr, r32, hi, negm, pB1, alB, l_reg, ps0, pa2, pa3); FIX(pA0, pA1, j + 1); SBAR();
        pv_d0(o, vb0 + sp * SHM_V, pa0, pa1, pa2, pa3); PSM(pA0, pA1, mnA, alA, false);
        RESC(alA);
        if (j + 3 < NT) { WAITBAR_G1(); } else { WAITBAR_FULL(); }
        if (j + 4 < NT) DMA_K(j + 4, sc); if (j + 3 < NT) DMA_V(j + 3, sp);
        ROT();
    }
    SBAR(); qkt_fin<MLA>(pB0, pB1, K_lds + sc * SHM_K, Kr_lds + sc * SHM_KR, qr, r32, hi, negm, pA1, alA, l_reg, ps0, pa2, pa3); FIX(pB0, pB1, NT - 1); SBAR();
    pv_d0(o, vb0 + sp * SHM_V, pa0, pa1, pa2, pa3); PSM(pB0, pB1, mnB, alB, false);
    RESC(alB);
    fin_p1(pB1, alB, l_reg, ps0, pa2, pa3); SBAR();
    pv_d0(o, vb0 + sc * SHM_V, pa0, pa1, pa2, pa3);
    if (hi == 0) li_l[r32] = l_reg; asm volatile("s_waitcnt lgkmcnt(0)" ::: "memory");
    float rli[16];
#pragma unroll
    for (int r = 0; r < 16; ++r) rli[r] = __builtin_amdgcn_rcpf(li_l[crow(r, hi)]);
    bf16_t* Ow = GQA4 ? Ob + (long)((wid & 1) * QBLK) * ldo + (wid >> 1) * 128 : Ob + (long)(wid * QBLK) * ldo;
#pragma unroll
    for (int r = 0; r < 16; ++r) { const int orow = crow(r, hi);
#pragma unroll
        for (int d0 = 0; d0 < 4; ++d0) *(GAS bf16_t*)(Ow + (long)orow * ldo + d0 * 32 + r32) = (bf16_t)(cvt_pk_bf16(o[d0][r] * rli[r], 0.f) & 0xffffu); }
    WAITBAR_FULL();
#undef DMA_K
#undef DMA_V
#undef WAITBAR_FULL
#undef WAITBAR_G1
#undef WAITBAR_G2
#undef RESC
#undef FIX
#undef ROT
#undef PSM
}
}

#define XB_TMO      128
#define XB_XCNT(j)  (256  + 64 * (j))
#define XB_XSUB(j)  (1280 + 64 * (j))
#define XB_XGEN(j)  (2304 + 64 * (j))
#define XB_TOP      3328
#define XB_TOPGEN   3392
#define XCD_BAR_WORDS 3456
#define XB_SPIN_CAP (1u << 22)
__device__ __forceinline__ unsigned xb_ld(unsigned* p)              { return __hip_atomic_load(p, __ATOMIC_RELAXED, __HIP_MEMORY_SCOPE_AGENT); }
__device__ __forceinline__ unsigned xb_add(unsigned* p, unsigned v) { return __hip_atomic_fetch_add(p, v, __ATOMIC_RELAXED, __HIP_MEMORY_SCOPE_AGENT); }
__device__ __forceinline__ unsigned xb_xcc_id() { return (unsigned)__builtin_amdgcn_s_getreg((3 << 11) | 20) & 0xFu; }
#define XB_SPIN(cond, bar) do { unsigned _sp = 0; while (cond) { __builtin_amdgcn_s_sleep(1); \
    if ((++_sp & 255u) == 0u) { if (xb_ld(&(bar)[XB_TMO])) break; if (_sp > XB_SPIN_CAP) { atomicAdd(&(bar)[XB_TMO], 1u); break; } } } } while (0)
struct XcdBarrier { unsigned* bar; unsigned x; volatile LAS unsigned* st; };
__device__ __forceinline__ XcdBarrier xcd_barrier_post(unsigned* bar, volatile LAS unsigned* st, int wave_s) {
    XcdBarrier b; b.bar = bar; b.x = xb_xcc_id(); b.st = st;
    if (tid_now(wave_s) == 0) (void)xb_add(&bar[XB_XCNT(b.x)], 1u);
    return b;
}
__device__ __forceinline__ void xcd_barrier_complete(unsigned* bar, unsigned x, unsigned& nloc, unsigned& nx) {
    const unsigned G = gridDim.x * gridDim.y * gridDim.z;
    unsigned sum, cnt, mine, sp = 0u;
    for (;;) {
        sum = 0u; cnt = 0u; mine = 0u;
#pragma unroll
        for (unsigned j = 0; j < 16; ++j) { const unsigned c = xb_ld(&bar[XB_XCNT(j)]); sum += c; cnt += (c > 0u) ? 1u : 0u; mine = (j == x) ? c : mine; }
        if (sum == G) break;
        __builtin_amdgcn_s_sleep(1);
        if ((++sp & 255u) == 0u) { if (xb_ld(&bar[XB_TMO])) break; if (sp > XB_SPIN_CAP) { atomicAdd(&bar[XB_TMO], 1u); break; } }
    }
    nloc = mine > 0u ? mine : 1u; nx = cnt > 0u ? cnt : 1u;
}
__device__ __forceinline__ void xcd_barrier(const XcdBarrier& b, int wave_s) {
    asm volatile("s_waitcnt vmcnt(0)" ::: "memory");
    __syncthreads();
    if (tid_now(wave_s) == 0) {
        unsigned* bar = b.bar;
        __builtin_amdgcn_s_waitcnt(0);
        unsigned nloc = b.st[0], nx = b.st[1];
        if (nloc == 0u) { xcd_barrier_complete(bar, b.x, nloc, nx); b.st[0] = nloc; b.st[1] = nx; }
        const unsigned old = xb_add(&bar[XB_XSUB(b.x)], 1u);
        const unsigned gen = old / nloc;
        if (old + 1u == (gen + 1u) * nloc) {
            __builtin_amdgcn_fence(__ATOMIC_RELEASE, "agent");
            asm volatile("s_waitcnt vmcnt(0)" ::: "memory");
            const unsigned og = xb_add(&bar[XB_TOP], 1u);
            const unsigned tg = og / nx;
            if (og + 1u == (tg + 1u) * nx) xb_add(&bar[XB_TOPGEN], 1u);
            else XB_SPIN(xb_ld(&bar[XB_TOPGEN]) == tg, bar);
            __builtin_amdgcn_fence(__ATOMIC_ACQUIRE, "agent");
            xb_add(&bar[XB_XGEN(b.x)], 1u);
            asm volatile("s_waitcnt vmcnt(0)" ::: "memory");
        } else {
            XB_SPIN(xb_ld(&bar[XB_XGEN(b.x)]) == gen, bar);
            __builtin_amdgcn_fence(__ATOMIC_ACQUIRE, "agent");
            asm volatile("s_waitcnt vmcnt(0)" ::: "memory");
        }
    }
    __syncthreads();
}

constexpr int NWAVES = 8;
constexpr int LDS_BYTES = 147456, LDSCTL_OFF = 147200;
static_assert(att::LDS_END <= LDSCTL_OFF && pg8::STAGE_BYTES + 1024 + 4096 <= LDSCTL_OFF && LDSCTL_OFF + 256 <= LDS_BYTES, "LDS map");

struct Args {
    const float* x; const float* p; const int* pos;
    const float* attn_norm; const float* w_in; const float* cq_norm; const float* ckv_norm; const float* w_uq; const float* w_ukv;
    const float* sink; const float* t5; const float* mla_on; const float* swa_on; const float* w_o; const float* ffn_norm;
    const float* w_gate; const float* w_up; const float* conv_w; const float* conv_b; const float* w_down;
    const float* pg_w; const float* pg_b; const float* pp_w; const float* final_norm;
    float* out; unsigned char* ws; int ph_lo, ph_hi;
};

template <int MODE>
__device__ __forceinline__ void transpose_item(const float* W, int K, int N, bf16_t* WT, int row_off, const float* kscale, LAS float* scr, int item, int lane) {
    const int nblk = N / 32, kb = item / nblk, nb = item % nblk, k0 = 64 * kb, n0 = 32 * nb;
    float tv[32];
#pragma unroll
    for (int i = 0; i < 32; ++i) { const int kk = 2 * i + (lane >> 5); tv[i] = *(const GAS float*)(W + (size_t)(k0 + kk) * N + n0 + (lane & 31)); }
#pragma unroll
    for (int i = 0; i < 32; ++i) { const int kk = 2 * i + (lane >> 5); float v = tv[i]; if (kscale) v *= kscale[k0 + kk]; scr[kk * 33 + (lane & 31)] = v; }
    asm volatile("s_waitcnt lgkmcnt(0)" ::: "memory");
    const int c = lane & 7;
#pragma unroll
    for (int j = 0; j < 4; ++j) { const int n = (lane >> 3) + 8 * j; const LAS float* s = scr + (8 * c) * 33 + n;
        u32x4 o; o.x = cvt_pk_bf16(s[0 * 33], s[1 * 33]); o.y = cvt_pk_bf16(s[2 * 33], s[3 * 33]); o.z = cvt_pk_bf16(s[4 * 33], s[5 * 33]); o.w = cvt_pk_bf16(s[6 * 33], s[7 * 33]);
        int nn = n0 + n;
        if (MODE == 1) { const int h = nn / 192, d = nn % 192; if (d >= 128) { const int e = d - 128; nn = h * 192 + 128 + 2 * (e & 31) + (e >> 5); } }
        if (MODE == 2) nn = (nn >> 7) * 256 + (nn & 127);
        *(GAS u32x4*)(WT + (size_t)(row_off + nn) * K + k0 + 8 * c) = o; }
    asm volatile("s_waitcnt lgkmcnt(0)" ::: "memory");
}

__device__ __forceinline__ int t5_bucket(int rel) {
    const int ret = rel > 0 ? 16 : 0; const int n = rel < 0 ? -rel : rel;
    if (n < 8) return ret + n;
    int large = 33 - __clz(n * n); if (large > 15) large = 15;
    return ret + large;
}

__global__ void __launch_bounds__(NWAVES * 64, 2) mk_fwd(Args a) {
    extern __shared__ __attribute__((aligned(16))) unsigned char lds[];
    cg::grid_group grid = cg::this_grid();
    const int G = gridDim.x, bx = blockIdx.x;
    const int vcu = (G % 8 == 0) ? (bx % 8) * (G / 8) + bx / 8 : bx;
    const int NGW = G * NWAVES;
    const int wave_s = __builtin_amdgcn_readfirstlane((int)threadIdx.x >> 6);
    { volatile LAS unsigned* ctl = (volatile LAS unsigned*)((LAS unsigned char*)lds + LDSCTL_OFF); const int t0 = tid_now(wave_s); if (t0 < 16) ctl[t0] = 0u; }
    __syncthreads();
    const XcdBarrier xbar = xcd_barrier_post((unsigned*)(a.ws + WS_BAR), (volatile LAS unsigned*)((LAS unsigned char*)lds + LDSCTL_OFF) + 8, wave_s);
    bool first_seam = true;
#define PHASE_IDS() int tid_ = tid_now(wave_s); asm volatile("" : "+v"(tid_)); const int tid = tid_, lane = tid & 63, wave = __builtin_amdgcn_readfirstlane(tid >> 6), gw = vcu * NWAVES + wave; (void)tid; (void)lane; (void)gw
    for (int ph2 = a.ph_lo * 2; ph2 < a.ph_hi * 2; ++ph2) {
        const int ph = ph2 >> 1;
        if (MK_DUP < 0 && (ph2 & 1)) continue;
        if (MK_DUP >= 0 && (ph2 & 1) && (ph % NPH_LAYER != MK_DUP || ph == NPHASE - 1)) continue;
        if (ph != NPHASE - 1 && ph % NPH_LAYER == 7) continue;
        if (ph2 > a.ph_lo * 2) { if (first_seam) { grid.sync(); first_seam = false; } else xcd_barrier(xbar, wave_s); }
    unsigned char* ws = a.ws; asm volatile("" : "+s"(ws));
    u64_t* ssq0 = (u64_t*)(ws + WS_SSQ0); u64_t* ssq1 = (u64_t*)(ws + WS_SSQ1); bf16_t* XB0 = (bf16_t*)(ws + WS_XB0); bf16_t* XB1 = (bf16_t*)(ws + WS_XB1);
    float* rsq = (float*)(ws + WS_RSQ); float* rskv = (float*)(ws + WS_RSKV); float* cst = (float*)(ws + WS_COS); float* snt = (float*)(ws + WS_SIN);
    bf16_t* KR = (bf16_t*)(ws + WS_KR); bf16_t* PB = (bf16_t*)(ws + WS_PB);
    bf16_t* Win_t = (bf16_t*)(ws + W_IN); bf16_t* Wuq_t = (bf16_t*)(ws + W_UQ); bf16_t* Wukv_t = (bf16_t*)(ws + W_UKV); bf16_t* Wo_t = (bf16_t*)(ws + W_O);
    bf16_t* Wgu_t = (bf16_t*)(ws + W_GU); bf16_t* Wd_t = (bf16_t*)(ws + W_D); bf16_t* Wpg_t = (bf16_t*)(ws + W_PG); bf16_t* Wpp_t = (bf16_t*)(ws + W_PP);
    bf16_t* H = (bf16_t*)(ws + WS_H); bf16_t* Z = (bf16_t*)(ws + WS_Z); bf16_t* Q = (bf16_t*)(ws + WS_Q); bf16_t* KV = (bf16_t*)(ws + WS_KV);
    bf16_t* ACT = (bf16_t*)(ws + WS_ACT); bf16_t* SBG = (bf16_t*)(ws + WS_SBG); bf16_t* SBU = (bf16_t*)(ws + WS_SBU); bf16_t* PG = (bf16_t*)(ws + WS_PG);
    LAS unsigned char* ldsl = (LAS unsigned char*)lds;

        const int L = ph / NPH_LAYER, q = (ph == NPHASE - 1) ? 99 : ph % NPH_LAYER;
        const float* xin = (L == 0) ? a.x : a.out;
        if (q == 0 && EN(0)) {
            PHASE_IDS();
            LAS float* scr = (LAS float*)(ldsl + wave * 16384);
            constexpr int I_IN = (DM / 64) * (INW / 32), I_UQ = (QRANK / 64) * (QW / 32), I_UKV = (KVRANK / 64) * (KVW / 32), I_O = (DM / 64) * (DM / 32),
                          I_G = (DM / 64) * (FF / 32), I_D = (FF / 64) * (DM / 32), I_PG = I_O, I_PP = (PLE / 64) * (DM / 32);
            constexpr int NITEMS = I_IN + I_UQ + I_UKV + I_O + 2 * I_G + I_D + I_PG + I_PP;
            for (int it = gw; it < NITEMS; it += NGW) {
                int r = it;
                if (r < I_IN) { transpose_item<0>(a.w_in + (size_t)L * DM * INW, DM, INW, Win_t, 0, a.attn_norm + L * DM, scr, r, lane); continue; } r -= I_IN;
                if (r < I_UQ) { transpose_item<1>(a.w_uq + (size_t)L * QRANK * QW, QRANK, QW, Wuq_t, 0, a.cq_norm + L * QRANK, scr, r, lane); continue; } r -= I_UQ;
                if (r < I_UKV) { transpose_item<0>(a.w_ukv + (size_t)L * KVRANK * KVW, KVRANK, KVW, Wukv_t, 0, a.ckv_norm + L * KVRANK, scr, r, lane); continue; } r -= I_UKV;
                if (r < I_O) { transpose_item<0>(a.w_o + (size_t)L * DM * DM, DM, DM, Wo_t, 0, nullptr, scr, r, lane); continue; } r -= I_O;
                if (r < I_G) { transpose_item<2>(a.w_gate + (size_t)L * DM * FF, DM, FF, Wgu_t, 0, a.ffn_norm + L * DM, scr, r, lane); continue; } r -= I_G;
                if (r < I_G) { transpose_item<2>(a.w_up + (size_t)L * DM * FF, DM, FF, Wgu_t, 128, a.ffn_norm + L * DM, scr, r, lane); continue; } r -= I_G;
                if (r < I_D) { transpose_item<0>(a.w_down + (size_t)L * FF * DM, FF, DM, Wd_t, 0, nullptr, scr, r, lane); continue; } r -= I_D;
                if (r < I_PG) { transpose_item<0>(a.pg_w + (size_t)L * DM * DM, DM, DM, Wpg_t, 0, nullptr, scr, r, lane); continue; } r -= I_PG;
                transpose_item<0>(a.pp_w + (size_t)L * PLE * DM, PLE, DM, Wpp_t, 0, nullptr, scr, r, lane);
            }
            { const unsigned z0 = opaque_zero(); const u32x4 zv = {z0, z0, z0, z0};
              for (int i = gw * 64 + lane; i < (ZW - INW) * DM / 8; i += NGW * 64) *(u32x4*)(Win_t + (size_t)INW * DM + (size_t)i * 8) = zv; }
            { const float* pl = a.p + (size_t)L * T * PLE;
              for (size_t i = (size_t)gw * 64 + lane; i < (size_t)T * PLE / 8; i += (size_t)NGW * 64) { const f32x4 v0 = *(const f32x4*)(pl + i * 8), v1 = *(const f32x4*)(pl + i * 8 + 4);
                  u32x4 w; w.x = cvt_pk_bf16(v0[0], v0[1]); w.y = cvt_pk_bf16(v0[2], v0[3]); w.z = cvt_pk_bf16(v1[0], v1[1]); w.w = cvt_pk_bf16(v1[2], v1[3]); *(u32x4*)(PB + i * 8) = w; } }
        }
        if (q == 0 && L == 0 && EN(7)) {
            PHASE_IDS();
            for (int m = gw; m < T; m += NGW) { const GAS f32x4* xr = (const GAS f32x4*)(a.x + (size_t)m * DM) + lane; f32x4 v[8]; float sm = 0.f;
#pragma unroll
                for (int j = 0; j < 8; ++j) { v[j] = xr[64 * j]; sm += (v[j].x * v[j].x + v[j].y * v[j].y) + (v[j].z * v[j].z + v[j].w * v[j].w); }
                sm = wave_sum(sm, lane); if (lane == 0) ssq0[m] = (u64_t)(sm * SSQ_FX + 0.5f);
                GAS u32x2* o8 = (GAS u32x2*)(XB0 + (size_t)m * DM) + lane;
#pragma unroll
                for (int j = 0; j < 8; ++j) { u32x2 w; w.x = cvt_pk_bf16(v[j].x, v[j].y); w.y = cvt_pk_bf16(v[j].z, v[j].w); o8[64 * j] = w; } }
        }
        if (q == 0) { }
        else if (q == 1 && EN(1)) {
            pg8::Gemm g{XB0, Win_t, T, ZW, DM, DM}; pg8::StaticOrder S; S.init(T, ZW, G, bx);
            pg8::EpiBf16 E{Z, ZW, nullptr, ssq0};
            pg8::gemm_phase<pg8::EpiBf16, true>(ldsl, g, S, E, wave_s);
        }
        else if (q == 2 && EN(2)) {
            PHASE_IDS();
            for (int m = gw; m < T; m += NGW) { const bf16_t* zr = Z + (size_t)m * ZW;
                float s1 = 0.f, s2 = 0.f;
                if (lane < 48) { const u32x4 w = *(const u32x4*)(zr + OFF_CQ + lane * 8);
#pragma unroll
                    for (int i = 0; i < 4; ++i) { const float lo = bf_lo(w[i]), hi = bf_hi(w[i]); s1 += lo * lo + hi * hi; } }
                if (lane < 32) { const u32x4 w = *(const u32x4*)(zr + OFF_CKV + lane * 8);
#pragma unroll
                    for (int i = 0; i < 4; ++i) { const float lo = bf_lo(w[i]), hi = bf_hi(w[i]); s2 += lo * lo + hi * hi; } }
                s1 = wave_sum(s1, lane); s2 = wave_sum(s2, lane);
                if (lane == 0) { rsq[m] = rsqrtf(s1 * (1.f / QRANK) + EPS); rskv[m] = rsqrtf(s2 * (1.f / KVRANK) + EPS); ssq0[m] = 0ull; ssq1[m] = 0ull; }
                if (lane < 32) { float c, s;
                    if (L == 0) { double invf = 1.0, bb = 0.7498942093324559;
#pragma unroll
                        for (int bit = 0; bit < 5; ++bit) { if ((lane >> bit) & 1) invf *= bb; bb *= bb; }
                        const double rev = (double)a.pos[m] * invf * 0.15915494309189535; const float fr = (float)(rev - rint(rev));
                        c = __builtin_amdgcn_cosf(fr); s = __builtin_amdgcn_sinf(fr); cst[(size_t)m * 32 + lane] = c; snt[(size_t)m * 32 + lane] = s; }
                    else { c = cst[(size_t)m * 32 + lane]; s = snt[(size_t)m * 32 + lane]; }
                    const float k1 = __uint_as_float((unsigned)zr[OFF_KR + lane] << 16), k2 = __uint_as_float((unsigned)zr[OFF_KR + 32 + lane] << 16);
                    *(unsigned*)(KR + (size_t)m * ROPE + 2 * lane) = cvt_pk_bf16(k1 * c - k2 * s, k1 * s + k2 * c); } }
        }
        else if (q == 3 && EN(3)) {
            { pg8::Gemm g{Z + OFF_CQ, Wuq_t, T, QW, QRANK, ZW}; pg8::StaticOrder S; S.init(T, QW, G, bx);
              pg8::EpiQ E{Q, rsq, cst, snt};
              pg8::gemm_phase<pg8::EpiQ, true>(ldsl, g, S, E, wave_s); }
            { pg8::Gemm g{Z + OFF_CKV, Wukv_t, T, KVW, KVRANK, ZW}; pg8::StaticOrder S; S.init(T, KVW, G, bx);
              pg8::EpiBf16 E{KV, KVW, rskv, nullptr};
              pg8::gemm_phase<pg8::EpiBf16, true>(ldsl, g, S, E, wave_s); }
        }
        else if (q == 4 && EN(4)) {
            constexpr int NQB = SEQ / 256, NU = BATCH * NH * NQB;
            for (int u = vcu; u < NU; u += G) { const int bh = u / NQB, qb = u % NQB, b = bh / NH, h = bh % NH; const size_t row0 = (size_t)b * SEQ;
                att::attn_unit<true, QW, KVW, DM>(Q + (row0 + (size_t)qb * 256) * QW + h * 192, KV + row0 * KVW + h * 256, KV + row0 * KVW + h * 256 + 128, KR + row0 * ROPE,
                                        H + (row0 + (size_t)qb * 256) * DM + h * 128, SEQ / 64, (char*)lds, 0, 0.f, wave_s); }
            for (int u = vcu; u < NU; u += G) { PHASE_IDS(); const int bk = u >> 8, qb64 = u & 255, b = bk >> 1, kvh = bk & 1; const size_t row0 = (size_t)b * SEQ;
                const int q0 = qb64 * 64; int key0 = q0 >= 128 ? q0 - 128 : 0; if (key0 > SEQ - 384) key0 = SEQ - 384;
                for (int i = tid; i < 4 * 768; i += NWAVES * 64) { const int hh = i / 768, rel = (i - hh * 768) - 384; ((float*)(lds + att::OFF_BT))[i] = (rel >= -128 && rel <= 128) ? a.t5[t5_bucket(rel) * NH + kvh * 4 + hh] : -1e30f; }
                __syncthreads();
                att::attn_unit<false, ZW, ZW, DM, true>(Z + (row0 + q0) * ZW + OFF_SQ + kvh * 512, Z + (row0 + key0) * ZW + OFF_SK + kvh * 128, Z + (row0 + key0) * ZW + OFF_SV + kvh * 128, nullptr,
                                         H + (row0 + q0) * DM + 1024 + kvh * 512, 6, (char*)lds, key0 - q0, a.sink[L * NH + kvh * 4 + (wave_s >> 1)], wave_s); }
        }
        else if (q == 5 && EN(5)) {
            PHASE_IDS();
            f32x4 gv[4][2];
#pragma unroll
            for (int j = 0; j < 4; ++j) { const int col = (lane + 64 * j) * 8; const float* gs = (col < 1024) ? a.mla_on + L * 1024 + col : a.swa_on + L * 1024 + (col - 1024);
                gv[j][0] = *(const f32x4*)gs; gv[j][1] = *(const f32x4*)(gs + 4); }
            for (int m = gw; m < T; m += NGW) { u32x4* hr = (u32x4*)(H + (size_t)m * DM) + lane; u32x4 w[4]; float s1 = 0.f, s2 = 0.f;
#pragma unroll
                for (int j = 0; j < 4; ++j) { w[j] = hr[64 * j]; float s = 0.f;
#pragma unroll
                    for (int i = 0; i < 4; ++i) { const float lo = bf_lo(w[j][i]), hi = bf_hi(w[j][i]); s += lo * lo + hi * hi; }
                    if (j < 2) s1 += s; else s2 += s; }
                s1 = wave_sum(s1, lane); s2 = wave_sum(s2, lane);
                const float r1 = rsqrtf(s1 * (1.f / 1024) + EPS), r2 = rsqrtf(s2 * (1.f / 1024) + EPS);
#pragma unroll
                for (int j = 0; j < 4; ++j) { const float rr = j < 2 ? r1 : r2; u32x4 o;
#pragma unroll
                    for (int i = 0; i < 4; ++i) { const float g0 = (i < 2) ? gv[j][0][2 * i] : gv[j][1][2 * i - 4], g1 = (i < 2) ? gv[j][0][2 * i + 1] : gv[j][1][2 * i - 3];
                        o[i] = cvt_pk_bf16(bf_lo(w[j][i]) * rr * g0, bf_hi(w[j][i]) * rr * g1); }
                    hr[64 * j] = o; } }
        }
        else if (q == 6 && EN(6)) {
            pg8::Gemm g{H, Wo_t, T, DM, DM, DM}; pg8::StaticOrder S; S.init(T, DM, G, bx);
            pg8::EpiRes E{a.x, (L == 0) ? nullptr : XB0, nullptr, XB1, ssq1};
            pg8::gemm_phase<pg8::EpiRes, true>(ldsl, g, S, E, wave_s);
        }
        else if (q == 8 && EN(8)) {
            pg8::Gemm g{XB1, Wgu_t, T, GUW, DM, DM}; pg8::StaticOrder S; S.init(T, GUW, G, bx);
            pg8::EpiGU E{ACT, SBG, SBU, a.conv_w + (size_t)L * 3 * FF, a.conv_b + (size_t)L * FF, (LAS float*)(ldsl + 132096), ssq1};
            pg8::gemm_phase<pg8::EpiGU, true>(ldsl, g, S, E, wave_s);
        }
        else if (q == 9 && EN(9)) {
            PHASE_IDS();
            constexpr int NCC = FF / 8, NIT = (T / 256) * 2 * NCC; const float* cw = a.conv_w + (size_t)L * 3 * FF; const float* cb = a.conv_b + (size_t)L * FF;
            for (int it = gw * 64 + lane; it < NIT; it += NGW * 64) { const int cc = it % NCC, rw = it / NCC, pm = rw >> 1, which = rw & 1, f0 = cc * 8;
                const size_t R = (size_t)pm * 256 + (which ? 255 : 0); const int sq = (int)(R % SEQ);
                const unsigned z0 = opaque_zero(); const u32x4 zv = {z0, z0, z0, z0};
                u32x4 gp, gc, gn, uu;
                if (which == 0) { gp = (sq == 0) ? zv : *(const GAS u32x4*)(SBG + ((size_t)(pm - 1) * 4 + 3) * FF + f0); gc = *(const GAS u32x4*)(SBG + ((size_t)pm * 4 + 0) * FF + f0); gn = *(const GAS u32x4*)(SBG + ((size_t)pm * 4 + 1) * FF + f0); }
                else { gp = *(const GAS u32x4*)(SBG + ((size_t)pm * 4 + 2) * FF + f0); gc = *(const GAS u32x4*)(SBG + ((size_t)pm * 4 + 3) * FF + f0); gn = (sq == SEQ - 1) ? zv : *(const GAS u32x4*)(SBG + ((size_t)(pm + 1) * 4 + 0) * FF + f0); }
                uu = *(const GAS u32x4*)(SBU + ((size_t)pm * 2 + which) * FF + f0); u32x4 o;
#pragma unroll
                for (int i = 0; i < 4; ++i) { const int f = f0 + 2 * i;
                    const float ga = bf_lo(gp[i]) * cw[f] + bf_lo(gc[i]) * cw[FF + f] + bf_lo(gn[i]) * cw[2 * FF + f] + cb[f];
                    const float gb = bf_hi(gp[i]) * cw[f + 1] + bf_hi(gc[i]) * cw[FF + f + 1] + bf_hi(gn[i]) * cw[2 * FF + f + 1] + cb[f + 1];
                    const float sa = ga * __builtin_amdgcn_rcpf(1.f + __expf(-ga)), sb = gb * __builtin_amdgcn_rcpf(1.f + __expf(-gb));
                    o[i] = cvt_pk_bf16(sa * bf_lo(uu[i]), sb * bf_hi(uu[i])); }
                *(GAS u32x4*)(ACT + R * FF + f0) = o; }
        }
        else if (q == 10 && EN(10)) {
            pg8::Gemm g{ACT, Wd_t, T, DM, FF, FF}; pg8::StaticOrder S; S.init(T, DM, G, bx);
            pg8::EpiRes E{nullptr, XB1, nullptr, H, nullptr};
            pg8::gemm_phase<pg8::EpiRes, true>(ldsl, g, S, E, wave_s);
        }
        else if (q == 11 && EN(11)) {
            pg8::Gemm g{PB, Wpp_t, T, DM, PLE, PLE}; pg8::StaticOrder S; S.init(T, DM, G, bx);
            pg8::EpiBf16 E{PG, DM, nullptr, nullptr};
            pg8::gemm_phase<pg8::EpiBf16, true>(ldsl, g, S, E, wave_s);
            asm volatile("s_waitcnt vmcnt(0)" ::: "memory"); __syncthreads();
        }
        if (q == 11 && EN(12)) {
            pg8::Gemm g{H, Wpg_t, T, DM, DM, DM}; pg8::StaticOrder S; S.init(T, DM, G, bx);
            pg8::EpiPle E{H, nullptr, a.pg_b + L * DM, PG, XB0, ssq0};
            pg8::gemm_phase<pg8::EpiPle, true>(ldsl, g, S, E, wave_s);
        }
        else if (q == 99 && EN(13)) {
            PHASE_IDS();
            f32x4 gv[4][2];
#pragma unroll
            for (int j = 0; j < 4; ++j) { gv[j][0] = *(const GAS f32x4*)(a.final_norm + (lane + 64 * j) * 8); gv[j][1] = *(const GAS f32x4*)(a.final_norm + (lane + 64 * j) * 8 + 4); }
            for (int m = gw; m < T; m += NGW) { const GAS u32x4* xr = (const GAS u32x4*)(XB0 + (size_t)m * DM) + lane; u32x4 w[4];
#pragma unroll
                for (int j = 0; j < 4; ++j) w[j] = xr[64 * j];
                const float rstd = rsqrtf((float)*(const GAS u64_t*)(ssq0 + m) * (SSQ_INV / DM) + EPS);
                GAS f32x4* orow = (GAS f32x4*)(a.out + (size_t)m * DM);
#pragma unroll
                for (int j = 0; j < 4; ++j) { const f32x4 v0 = {bf_lo(w[j].x), bf_hi(w[j].x), bf_lo(w[j].y), bf_hi(w[j].y)}, v1 = {bf_lo(w[j].z), bf_hi(w[j].z), bf_lo(w[j].w), bf_hi(w[j].w)};
                    orow[(lane + 64 * j) * 2] = v0 * rstd * gv[j][0]; orow[(lane + 64 * j) * 2 + 1] = v1 * rstd * gv[j][1]; } }
        }
    }
}

extern "C" void kernel_launch(void* const* d_in, const int* in_sizes, int n_in, void* d_out, int out_size, void* d_ws, size_t ws_size, hipStream_t stream) {
    static int grid = 0;
    if (grid == 0) {
        if (n_in != 24 || out_size != T * DM || ws_size < WS_NEED) { fprintf(stderr, "kernel_launch: unexpected shapes (n_in %d out %d ws %zu need %zu)\n", n_in, out_size, ws_size, (size_t)WS_NEED); grid = -1; return; }
        int dev = 0, cus = 0, per_cu = 0;
        hipGetDevice(&dev); hipDeviceGetAttribute(&cus, hipDeviceAttributeMultiprocessorCount, dev);
        if (hipFuncSetAttribute((const void*)mk_fwd, hipFuncAttributeMaxDynamicSharedMemorySize, LDS_BYTES) != hipSuccess) { fprintf(stderr, "kernel_launch: hipFuncSetAttribute failed\n"); grid = -1; return; }
        if (hipOccupancyMaxActiveBlocksPerMultiprocessor(&per_cu, (const void*)mk_fwd, NWAVES * 64, LDS_BYTES) != hipSuccess || per_cu < 1) { fprintf(stderr, "kernel_launch: occupancy query says %d\n", per_cu); per_cu = 1; }
        (void)hipGetLastError();
        grid = cus * 1;
        fprintf(stderr, "kernel_launch: grid %d (cus %d, per_cu %d)\n", grid, cus, per_cu);
    }
    if (grid < 0) return;
    if (hipMemsetAsync((char*)d_ws + WS_BAR, 0, WS_BAR_BYTES, stream) != hipSuccess) { fprintf(stderr, "kernel_launch: memset failed\n"); return; }
    Args a{};
    a.x = (const float*)d_in[0]; a.p = (const float*)d_in[1]; a.pos = (const int*)d_in[2];
    a.attn_norm = (const float*)d_in[3]; a.w_in = (const float*)d_in[4]; a.cq_norm = (const float*)d_in[5]; a.ckv_norm = (const float*)d_in[6];
    a.w_uq = (const float*)d_in[7]; a.w_ukv = (const float*)d_in[8]; a.sink = (const float*)d_in[9]; a.t5 = (const float*)d_in[10];
    a.mla_on = (const float*)d_in[11]; a.swa_on = (const float*)d_in[12]; a.w_o = (const float*)d_in[13]; a.ffn_norm = (const float*)d_in[14];
    a.w_gate = (const float*)d_in[15]; a.w_up = (const float*)d_in[16]; a.conv_w = (const float*)d_in[17]; a.conv_b = (const float*)d_in[18]; a.w_down = (const float*)d_in[19];
    a.pg_w = (const float*)d_in[20]; a.pg_b = (const float*)d_in[21]; a.pp_w = (const float*)d_in[22]; a.final_norm = (const float*)d_in[23];
    a.out = (float*)d_out; a.ws = (unsigned char*)d_ws;
#if MK_MULTI
    for (int ph = 0; ph < NPHASE; ++ph) { a.ph_lo = ph; a.ph_hi = ph + 1; void* args[] = {&a};
        hipError_t e = hipLaunchCooperativeKernel((const void*)mk_fwd, dim3(grid), dim3(NWAVES * 64), args, LDS_BYTES, stream);
        if (e != hipSuccess) { fprintf(stderr, "kernel_launch: launch %d failed: %s\n", ph, hipGetErrorString(e)); break; } }
#else
    a.ph_lo = 0; a.ph_hi = NPHASE; void* args[] = {&a};
    hipError_t e = hipLaunchCooperativeKernel((const void*)mk_fwd, dim3(grid), dim3(NWAVES * 64), args, LDS_BYTES, stream);
    if (e != hipSuccess) fprintf(stderr, "kernel_launch: cooperative launch failed: %s (grid %d)\n", hipGetErrorString(e), grid);
#endif
}
```

```cpp
#include <hip/hip_runtime.h>
#include <hip/hip_cooperative_groups.h>
#include <cstdio>
#include <cstdint>
namespace cg = cooperative_groups;

#ifndef MK_PHMASK
#define MK_PHMASK 0xFFFFFFFFu
#endif
#define EN(k) (((MK_PHMASK) >> (k)) & 1u)
#ifndef MK_DUP
#define MK_DUP -1
#endif
#ifndef MK_MULTI
#define MK_MULTI 0
#endif

constexpr int BATCH = 2, SEQ = 16384, T = BATCH * SEQ, DM = 2048, DEPTH = 2, PLE = 256;
constexpr int QRANK = 384, KVRANK = 256, ROPE = 64, NH = 8;
constexpr int INW = 2240, ZW = 2304;
constexpr int OFF_CQ = 0, OFF_CKV = 384, OFF_KR = 640, OFF_SQ = 704, OFF_SK = 1728, OFF_SV = 1984;
constexpr int QW = 1536, KVW = 2048, FF = 5504, GUW = 2 * FF;
constexpr float EPS = 1e-6f;
constexpr int NPH_LAYER = 12, NPHASE = DEPTH * NPH_LAYER + 1;

constexpr size_t MiB = 1u << 20;
constexpr size_t WS_RSQ = 0, WS_RSKV = 256 * 1024, WS_COS = 1 * MiB, WS_SIN = 5 * MiB;
constexpr size_t WS_BAR = 512 * 1024, WS_BAR_BYTES = 16384;
constexpr size_t WS_SSQ0 = 896 * MiB, WS_SSQ1 = 897 * MiB;
constexpr float SSQ_FX = 65536.f, SSQ_INV = 1.f / 65536.f;
constexpr size_t WS_KR = 9 * MiB;
constexpr size_t WS_PB = 13 * MiB;
constexpr size_t WS_W = 29 * MiB;
constexpr size_t W_IN = WS_W, W_UQ = W_IN + (size_t)ZW * DM * 2, W_UKV = W_UQ + (size_t)QW * QRANK * 2, W_O = W_UKV + (size_t)KVW * KVRANK * 2,
                 W_GU = W_O + (size_t)DM * DM * 2, W_D = W_GU + (size_t)GUW * DM * 2, W_PG = W_D + (size_t)DM * FF * 2, W_PP = W_PG + (size_t)DM * DM * 2,
                 W_END = W_PP + (size_t)DM * PLE * 2;
constexpr size_t WS_H = 126 * MiB;
constexpr size_t WS_BIG = 254 * MiB;
constexpr size_t WS_Z = WS_BIG, WS_Q = WS_Z + (size_t)T * ZW * 2, WS_KV = WS_Q + (size_t)T * QW * 2, WS_KV_END = WS_KV + (size_t)T * KVW * 2;
constexpr size_t WS_ACT = WS_BIG, WS_ACT_END = WS_ACT + (size_t)T * FF * 2;
constexpr size_t WS_SBG = 622 * MiB, WS_SBU = WS_SBG + (size_t)(T / 256) * 4 * FF * 2, WS_SB_END = WS_SBU + (size_t)(T / 256) * 2 * FF * 2;
constexpr size_t WS_PG = WS_BIG;
constexpr size_t WS_XB1 = 640 * MiB, WS_XB0 = 768 * MiB, WS_NEED = WS_SSQ1 + (size_t)T * 8;
static_assert(W_END <= WS_H && WS_H + (size_t)T * DM * 2 <= WS_BIG && WS_KV_END <= WS_SBG && WS_ACT_END <= WS_SBG && WS_SB_END <= WS_XB1 && WS_NEED <= (size_t)1024 * MiB, "ws map");

#define LAS __attribute__((address_space(3)))
#define GAS __attribute__((address_space(1)))
typedef unsigned short bf16_t;
typedef short bf16x8 __attribute__((ext_vector_type(8)));
typedef short s16x4 __attribute__((ext_vector_type(4)));
typedef float f32x4 __attribute__((ext_vector_type(4)));
typedef float f32x8 __attribute__((ext_vector_type(8)));
typedef float f32x16 __attribute__((ext_vector_type(16)));
typedef unsigned u32x4 __attribute__((ext_vector_type(4)));
typedef unsigned u32x2 __attribute__((ext_vector_type(2)));
typedef unsigned long long u64_t;

__device__ __forceinline__ unsigned cvt_pk_bf16(float lo, float hi) { unsigned r; asm volatile("v_cvt_pk_bf16_f32 %0, %1, %2" : "=v"(r) : "v"(lo), "v"(hi)); return r; }
__device__ __forceinline__ int tid_now(int wave_s) { int z; asm volatile("v_mov_b32 %0, 0" : "=v"(z)); return wave_s * 64 + (int)__builtin_amdgcn_mbcnt_hi(~0u, __builtin_amdgcn_mbcnt_lo(~0u, (unsigned)z)); }
__device__ __forceinline__ unsigned opaque_zero() { unsigned z; asm volatile("v_mov_b32 %0, 0" : "=v"(z)); return z; }
__device__ __forceinline__ float bf_lo(unsigned w) { return __uint_as_float(w << 16); }
__device__ __forceinline__ float bf_hi(unsigned w) { return __uint_as_float(w & 0xffff0000u); }
__device__ __forceinline__ float wave_sum(float v, int lane) {
#pragma unroll
    for (int o = 1; o < 64; o <<= 1) v += __int_as_float(__builtin_amdgcn_ds_bpermute((lane ^ o) << 2, __float_as_int(v)));
    return v;
}

namespace pg8 {
constexpr int BM = 256, BK = 64, HALF = 128, HTB = HALF * BK * 2, STAGE_BYTES = 8 * HTB, NXCD = 8, WGM = 4;
__host__ __device__ __forceinline__ int lds_byte(int r, int c) { const int st = (r >> 4) * 2 + (c >> 5), rr = r & 15, cc = c & 31, ob = rr * 64 + cc * 2; return st * 1024 + (ob ^ (((ob >> 9) & 1) << 5)); }
__host__ __device__ __forceinline__ void stage_rc(int b, int& R, int& C) { const int st = b / 1024, sb = b % 1024, swz = sb ^ (((sb >> 9) & 1) << 5); R = (st >> 1) * 16 + swz / 64; C = (st & 1) * 32 + (swz % 64) / 2; }
__host__ __device__ __forceinline__ int perm32(int rho) { const int n = rho >> 4, i = rho & 15; return 8 * (i >> 2) + 4 * n + (i & 3); }

struct Unit { int pm, pn; };
struct Gemm { const bf16_t* A; const bf16_t* Bt; int M, N, K, lda; };

struct StaticOrder {
    int nM, nN, nwg, G, c;
    __device__ void init(int M, int N, int G_, int c_) { nM = M / BM; nN = N / BM; nwg = nM * nN; G = G_; c = c_; }
    __device__ bool next(int i, Unit& u) const {
        const long L = (long)i * G + c; if (L >= nwg) return false;
        int wgid = (int)L; { const int q = nwg / NXCD, r = nwg % NXCD, xcd = wgid % NXCD, off = wgid / NXCD; wgid = (xcd < r ? xcd * (q + 1) : r * (q + 1) + (xcd - r) * q) + off; }
        const int nig = WGM * nN, gid = wgid / nig, fm = gid * WGM, gsz = (nM - fm) < WGM ? (nM - fm) : WGM;
        u.pm = fm + ((wgid % nig) % gsz); u.pn = (wgid % nig) / gsz; return true;
    }
};

struct EpiBf16 {
    bf16_t* O; int ldc; const float* rs; const u64_t* ssqp;
    __device__ __forceinline__ void operator()(const f32x4 (&acc)[2][2][4][2], const Unit& u, int wr, int wc, int fr, int fq) const {
        const int row0 = u.pm * BM + wr * 64 + fr, col0 = u.pn * BM + wc * 32 + 8 * fq;
#pragma unroll
        for (int ai = 0; ai < 2; ++ai)
#pragma unroll
            for (int m = 0; m < 4; ++m) { const int r = row0 + ai * HALF + m * 16; float s = rs ? *(const GAS float*)(rs + r) : 1.f; if (ssqp) s = rsqrtf((float)*(const GAS u64_t*)(ssqp + r) * (SSQ_INV / DM) + EPS); bf16_t* rowp = O + (size_t)r * ldc + col0;
#pragma unroll
                for (int bj = 0; bj < 2; ++bj) { const f32x4 v0 = acc[ai][bj][m][0] * s, v1 = acc[ai][bj][m][1] * s;
                    u32x4 w; w.x = cvt_pk_bf16(v0[0], v0[1]); w.y = cvt_pk_bf16(v0[2], v0[3]); w.z = cvt_pk_bf16(v1[0], v1[1]); w.w = cvt_pk_bf16(v1[2], v1[3]);
                    *(GAS u32x4*)(rowp + bj * HALF) = w; } }
    }
};
struct EpiQ {
    bf16_t* O; const float* rs; const float* cs; const float* sn;
    __device__ __forceinline__ void operator()(const f32x4 (&acc)[2][2][4][2], const Unit& u, int wr, int wc, int fr, int fq) const {
        const int row0 = u.pm * BM + wr * 64 + fr, col0 = u.pn * BM + wc * 32 + 8 * fq;
#pragma unroll
        for (int bj = 0; bj < 2; ++bj) {
            const int cb = u.pn * BM + bj * HALF + wc * 32, d = cb % 192; const bool rope = d >= 128; const int j0 = ((d - 128) >> 1) + 4 * fq;
#pragma unroll
            for (int ai = 0; ai < 2; ++ai)
#pragma unroll
                for (int m = 0; m < 4; ++m) { const int r = row0 + ai * HALF + m * 16; const float s = *(const GAS float*)(rs + r) * 0.10411754831265403f;
                    f32x4 v0 = acc[ai][bj][m][0] * s, v1 = acc[ai][bj][m][1] * s;
                    if (rope) { const f32x4 c4 = *(const GAS f32x4*)(cs + (size_t)r * 32 + j0), s4 = *(const GAS f32x4*)(sn + (size_t)r * 32 + j0);
                        f32x4 a, b; a[0] = v0[0] * c4[0] - v0[1] * s4[0]; a[1] = v0[0] * s4[0] + v0[1] * c4[0]; a[2] = v0[2] * c4[1] - v0[3] * s4[1]; a[3] = v0[2] * s4[1] + v0[3] * c4[1];
                        b[0] = v1[0] * c4[2] - v1[1] * s4[2]; b[1] = v1[0] * s4[2] + v1[1] * c4[2]; b[2] = v1[2] * c4[3] - v1[3] * s4[3]; b[3] = v1[2] * s4[3] + v1[3] * c4[3]; v0 = a; v1 = b; }
                    u32x4 w; w.x = cvt_pk_bf16(v0[0], v0[1]); w.y = cvt_pk_bf16(v0[2], v0[3]); w.z = cvt_pk_bf16(v1[0], v1[1]); w.w = cvt_pk_bf16(v1[2], v1[3]);
                    *(GAS u32x4*)(O + (size_t)r * QW + col0 + bj * HALF) = w; }
        }
    }
};
__device__ __forceinline__ float dpp_f(float oldv, float src, int ctrl_sel) {
    const int o = __float_as_int(oldv), v = __float_as_int(src); int r;
    if (ctrl_sel == 0) r = __builtin_amdgcn_update_dpp(o, v, 0x111, 0xf, 0xf, false);
    else if (ctrl_sel == 1) r = __builtin_amdgcn_update_dpp(o, v, 0x101, 0xf, 0xf, false);
    else if (ctrl_sel == 2) r = __builtin_amdgcn_update_dpp(o, v, 0x121, 0xf, 0xf, false);
    else r = __builtin_amdgcn_update_dpp(o, v, 0x12F, 0xf, 0xf, false);
    return __int_as_float(r);
}
struct EpiGU {
    bf16_t* ACT; bf16_t* SBG; bf16_t* SBU; const float* cw; const float* cb; LAS float* X; const u64_t* ssq;
    __device__ __forceinline__ void operator()(const f32x4 (&acc)[2][2][4][2], const Unit& u, int wr, int wc, int fr_, int fq_) const {
        int fr = fr_, fq = fq_; asm volatile("" : "+v"(fr), "+v"(fq));
        const int colf = u.pn * HALF + wc * 32 + 8 * fq;
        float rs[2][4];
#pragma unroll
        for (int ai = 0; ai < 2; ++ai)
#pragma unroll
            for (int m = 0; m < 4; ++m) rs[ai][m] = rsqrtf((float)*(const GAS u64_t*)(ssq + (size_t)u.pm * BM + ai * HALF + wr * 64 + m * 16 + fr) * (SSQ_INV / DM) + EPS);
#pragma unroll
        for (int ai = 0; ai < 2; ++ai) { const int bidx = 2 * ai + wr; LAS float* xb = X + ((bidx * 4 + wc) * 2) * 32 + fq * 8;
            if (fr == 0) { *(LAS f32x4*)(xb) = acc[ai][0][0][0] * rs[ai][0]; *(LAS f32x4*)(xb + 4) = acc[ai][0][0][1] * rs[ai][0]; }
            if (fr == 15) { *(LAS f32x4*)(xb + 32) = acc[ai][0][3][0] * rs[ai][3]; *(LAS f32x4*)(xb + 36) = acc[ai][0][3][1] * rs[ai][3]; } }
        asm volatile("s_waitcnt lgkmcnt(0)\n\ts_barrier" ::: "memory");
#pragma unroll
        for (int n = 0; n < 2; ++n) {
            const f32x4 w0 = *(const GAS f32x4*)(cw + colf + 4 * n), w1 = *(const GAS f32x4*)(cw + FF + colf + 4 * n), w2 = *(const GAS f32x4*)(cw + 2 * FF + colf + 4 * n), bb = *(const GAS f32x4*)(cb + colf + 4 * n);
#pragma unroll
            for (int ai = 0; ai < 2; ++ai) { const int bidx = 2 * ai + wr;
                f32x4 ep = (f32x4){0.f, 0.f, 0.f, 0.f}, en = (f32x4){0.f, 0.f, 0.f, 0.f};
                if (bidx > 0) ep = *(const LAS f32x4*)(X + (((bidx - 1) * 4 + wc) * 2 + 1) * 32 + fq * 8 + 4 * n);
                if (bidx < 3) en = *(const LAS f32x4*)(X + (((bidx + 1) * 4 + wc) * 2) * 32 + fq * 8 + 4 * n);
                f32x4 gs[4];
#pragma unroll
                for (int m = 0; m < 4; ++m) gs[m] = acc[ai][0][m][n] * rs[ai][m];
#pragma unroll
                for (int m = 0; m < 4; ++m) { const int rt = ai * HALF + wr * 64 + m * 16 + fr; const size_t r = (size_t)u.pm * BM + rt; float ov[4];
#pragma unroll
                    for (int i = 0; i < 4; ++i) { const float g = gs[m][i];
                        const float oldp = (m > 0) ? dpp_f(0.f, gs[m > 0 ? m - 1 : 0][i], 2) : ep[i];
                        const float gp = dpp_f(oldp, g, 0);
                        const float oldn = (m < 3) ? dpp_f(0.f, gs[m < 3 ? m + 1 : 3][i], 3) : en[i];
                        const float gn = dpp_f(oldn, g, 1);
                        const float c = w0[i] * gp + w1[i] * g + w2[i] * gn + bb[i];
                        ov[i] = c * __builtin_amdgcn_rcpf(1.f + __expf(-c)) * (acc[ai][1][m][n][i] * rs[ai][m]); }
                    u32x2 wv; wv.x = cvt_pk_bf16(ov[0], ov[1]); wv.y = cvt_pk_bf16(ov[2], ov[3]);
                    *(GAS u32x2*)(ACT + r * FF + colf + 4 * n) = wv;
                    if (rt < 2 || rt >= 254) {
                        const int si = rt < 2 ? rt : rt - 252; const f32x4 g0 = gs[m]; u32x2 gw; gw.x = cvt_pk_bf16(g0[0], g0[1]); gw.y = cvt_pk_bf16(g0[2], g0[3]);
                        *(GAS u32x2*)(SBG + ((size_t)u.pm * 4 + si) * FF + colf + 4 * n) = gw;
                        if (rt == 0 || rt == 255) { const f32x4 u0 = acc[ai][1][m][n] * rs[ai][m]; u32x2 uw; uw.x = cvt_pk_bf16(u0[0], u0[1]); uw.y = cvt_pk_bf16(u0[2], u0[3]);
                            *(GAS u32x2*)(SBU + ((size_t)u.pm * 2 + (rt ? 1 : 0)) * FF + colf + 4 * n) = uw; } } }
            }
        }
    }
};
__device__ __forceinline__ void ssq_commit(u64_t* ssq, float (&q)[2][4], int row0, int fr, int fq) {
    const int lane = fq * 16 + fr;
#pragma unroll
    for (int ai = 0; ai < 2; ++ai)
#pragma unroll
        for (int m = 0; m < 4; ++m) { float v = q[ai][m];
            v += __int_as_float(__builtin_amdgcn_ds_bpermute((lane ^ 16) << 2, __float_as_int(v)));
            v += __int_as_float(__builtin_amdgcn_ds_bpermute((lane ^ 32) << 2, __float_as_int(v)));
            if (fq == 0) __hip_atomic_fetch_add(ssq + row0 + ai * HALF + m * 16, (u64_t)(v * SSQ_FX + 0.5f), __ATOMIC_RELAXED, __HIP_MEMORY_SCOPE_AGENT); }
}
struct EpiRes {
    const float* base; const bf16_t* baseb; float* out; bf16_t* xb; u64_t* ssq;
    __device__ __forceinline__ void operator()(const f32x4 (&acc)[2][2][4][2], const Unit& u, int wr, int wc, int fr, int fq) const {
        const int row0 = u.pm * BM + wr * 64 + fr, col0 = u.pn * BM + wc * 32 + 8 * fq;
        float q[2][4];
#pragma unroll
        for (int ai = 0; ai < 2; ++ai)
#pragma unroll
            for (int m = 0; m < 4; ++m) { const size_t off = (size_t)(row0 + ai * HALF + m * 16) * DM + col0; q[ai][m] = 0.f;
#pragma unroll
                for (int bj = 0; bj < 2; ++bj) { f32x4 b0, b1;
                    if (baseb) { const u32x4 bw = *(const GAS u32x4*)(baseb + off + bj * HALF); b0 = (f32x4){bf_lo(bw.x), bf_hi(bw.x), bf_lo(bw.y), bf_hi(bw.y)}; b1 = (f32x4){bf_lo(bw.z), bf_hi(bw.z), bf_lo(bw.w), bf_hi(bw.w)}; }
                    else { b0 = *(const GAS f32x4*)(base + off + bj * HALF); b1 = *(const GAS f32x4*)(base + off + bj * HALF + 4); }
                    const f32x4 o0 = b0 + acc[ai][bj][m][0], o1 = b1 + acc[ai][bj][m][1];
                    if (out) { *(GAS f32x4*)(out + off + bj * HALF) = o0; *(GAS f32x4*)(out + off + bj * HALF + 4) = o1; }
                    q[ai][m] += (o0[0] * o0[0] + o0[1] * o0[1]) + (o0[2] * o0[2] + o0[3] * o0[3]) + (o1[0] * o1[0] + o1[1] * o1[1]) + (o1[2] * o1[2] + o1[3] * o1[3]);
                    if (xb) { u32x4 w; w.x = cvt_pk_bf16(o0[0], o0[1]); w.y = cvt_pk_bf16(o0[2], o0[3]); w.z = cvt_pk_bf16(o1[0], o1[1]); w.w = cvt_pk_bf16(o1[2], o1[3]); *(GAS u32x4*)(xb + off + bj * HALF) = w; } } }
        if (ssq) ssq_commit(ssq, q, row0, fr, fq);
    }
};
struct EpiPle {
    const bf16_t* baseb; float* out; const float* bias; const bf16_t* pp; bf16_t* xb; u64_t* ssq;
    __device__ __forceinline__ void operator()(const f32x4 (&acc)[2][2][4][2], const Unit& u, int wr, int wc, int fr, int fq) const {
        const int row0 = u.pm * BM + wr * 64 + fr, col0 = u.pn * BM + wc * 32 + 8 * fq;
        f32x4 bv[2][2]; float q[2][4];
#pragma unroll
        for (int bj = 0; bj < 2; ++bj) { bv[bj][0] = *(const GAS f32x4*)(bias + col0 + bj * HALF); bv[bj][1] = *(const GAS f32x4*)(bias + col0 + bj * HALF + 4); }
#pragma unroll
        for (int ai = 0; ai < 2; ++ai)
#pragma unroll
            for (int m = 0; m < 4; ++m) { const size_t off = (size_t)(row0 + ai * HALF + m * 16) * DM + col0; q[ai][m] = 0.f;
#pragma unroll
                for (int bj = 0; bj < 2; ++bj) { const u32x4 bw = *(const GAS u32x4*)(baseb + off + bj * HALF);
                    const f32x4 b0 = {bf_lo(bw.x), bf_hi(bw.x), bf_lo(bw.y), bf_hi(bw.y)}, b1 = {bf_lo(bw.z), bf_hi(bw.z), bf_lo(bw.w), bf_hi(bw.w)};
                    const u32x4 pw = *(const GAS u32x4*)(pp + off + bj * HALF);
                    const f32x4 p0 = {bf_lo(pw.x), bf_hi(pw.x), bf_lo(pw.y), bf_hi(pw.y)}, p1 = {bf_lo(pw.z), bf_hi(pw.z), bf_lo(pw.w), bf_hi(pw.w)};
                    const f32x4 z0 = acc[ai][bj][m][0] + bv[bj][0], z1 = acc[ai][bj][m][1] + bv[bj][1]; f32x4 g0, g1;
#pragma unroll
                    for (int i = 0; i < 4; ++i) { g0[i] = __builtin_amdgcn_rcpf(1.f + __expf(-z0[i])); g1[i] = __builtin_amdgcn_rcpf(1.f + __expf(-z1[i])); }
                    const f32x4 o0 = b0 + g0 * p0, o1 = b1 + g1 * p1;
                    if (out) { *(GAS f32x4*)(out + off + bj * HALF) = o0; *(GAS f32x4*)(out + off + bj * HALF + 4) = o1; }
                    if (xb) { q[ai][m] += (o0[0] * o0[0] + o0[1] * o0[1]) + (o0[2] * o0[2] + o0[3] * o0[3]) + (o1[0] * o1[0] + o1[1] * o1[1]) + (o1[2] * o1[2] + o1[3] * o1[3]);
                        u32x4 w; w.x = cvt_pk_bf16(o0[0], o0[1]); w.y = cvt_pk_bf16(o0[2], o0[3]); w.z = cvt_pk_bf16(o1[0], o1[1]); w.w = cvt_pk_bf16(o1[2], o1[3]); *(GAS u32x4*)(xb + off + bj * HALF) = w; } } }
        if (xb) ssq_commit(ssq, q, row0, fr, fq);
    }
};

template <class Epi, bool ALIGN_EPI>
__device__ __forceinline__ void gemm_phase(LAS unsigned char* lds, const Gemm g, const StaticOrder& S, const Epi& E, const int wave_s) {
    int tid_ = tid_now(wave_s); asm volatile("" : "+v"(tid_));
    const int tid = tid_, wid = __builtin_amdgcn_readfirstlane(tid >> 6), lane = tid & 63, wr = wid >> 2, wc = wid & 3, fr = lane & 15, fq = lane >> 4;
    int K_ = g.K, lda_ = g.lda; asm volatile("" : "+s"(K_), "+s"(lda_));
    const int K = K_, nt = K / BK, lda = lda_;
    unsigned voffA[2], voffB[2];
#pragma unroll
    for (int i = 0; i < 2; ++i) { int R, C; stage_rc(tid * 16 + i * 8192, R, C); const int Rb = (R & ~31) + perm32(R & 31);
        voffA[i] = (unsigned)(R * lda + C) * 2u; voffB[i] = (unsigned)(Rb * K + C) * 2u; }
    const size_t kstep = (size_t)(BK * 2);
    const size_t hstepA = (size_t)HALF * lda * 2, hstepB = (size_t)HALF * K * 2;
    const size_t tstepA = 2 * hstepA, tstepB = 2 * hstepB;
    const unsigned ldsw = (unsigned)wid * 1024u;
    const int aoff = lds_byte(wr * 64 + fr, fq * 8), boff = lds_byte(wc * 32 + fr, fq * 8);
#define PG8_SA(b, h) (((b) * 2 + (h)) * HTB)
#define PG8_SB(b, h) ((4 + (b) * 2 + (h)) * HTB)
#define PG8_STAGE(bufoff, gbase, voff) do { _Pragma("unroll") for (int _i = 0; _i < 2; ++_i) \
        __builtin_amdgcn_global_load_lds((const unsigned*)((const char*)(gbase) + (voff)[_i]), (LAS unsigned*)(lds + (bufoff) + ldsw + _i * 8192), 16, 0, 0); } while (0)
#define PG8_LDA(dst, b, h) do { _Pragma("unroll") for (int m = 0; m < 4; ++m) _Pragma("unroll") for (int k = 0; k < 2; ++k) dst[m][k] = *(const LAS bf16x8*)(lds + PG8_SA(b, h) + aoff + m * 2048 + k * 1024); } while (0)
#define PG8_LDB(dst, b, h) do { _Pragma("unroll") for (int n = 0; n < 2; ++n) _Pragma("unroll") for (int k = 0; k < 2; ++k) dst[n][k] = *(const LAS bf16x8*)(lds + PG8_SB(b, h) + boff + n * 2048 + k * 1024); } while (0)
#define PG8_MMA(ai, bj, At, Bt) do { __builtin_amdgcn_s_setprio(1); _Pragma("unroll") for (int m = 0; m < 4; ++m) _Pragma("unroll") for (int n = 0; n < 2; ++n) _Pragma("unroll") for (int k = 0; k < 2; ++k) \
        acc[ai][bj][m][n] = __builtin_amdgcn_mfma_f32_16x16x32_bf16(Bt[n][k], At[m][k], acc[ai][bj][m][n], 0, 0, 0); __builtin_amdgcn_s_setprio(0); } while (0)
#define PG8_WAIT_V(n) asm volatile("s_waitcnt vmcnt(" #n ")" ::: "memory")
#define PG8_WAIT_L(n) asm volatile("s_waitcnt lgkmcnt(" #n ")" ::: "memory")
#define PG8_BAR __builtin_amdgcn_s_barrier()
#define PG8_SCHED __builtin_amdgcn_sched_barrier(0)
    Unit cur, nxt; int ui = 0;
    if (!S.next(0, cur)) return;
    f32x4 acc[2][2][4][2];
    float zz0; asm volatile("v_mov_b32 %0, 0" : "=v"(zz0));
#pragma unroll
    for (int a = 0; a < 2; ++a)
#pragma unroll
        for (int b = 0; b < 2; ++b)
#pragma unroll
            for (int m = 0; m < 4; ++m)
#pragma unroll
                for (int n = 0; n < 2; ++n) acc[a][b][m][n] = (f32x4){zz0, zz0, zz0, zz0};
    bf16x8 At[4][2], B0[2][2], B1[2][2];
    const char* cA = (const char*)g.A + (size_t)cur.pm * tstepA; const char* cB = (const char*)g.Bt + (size_t)cur.pn * tstepB;
    PG8_STAGE(PG8_SB(0, 0), cB, voffB); PG8_STAGE(PG8_SB(0, 1), cB + hstepB, voffB); PG8_STAGE(PG8_SA(0, 0), cA, voffA); PG8_STAGE(PG8_SA(0, 1), cA + hstepA, voffA);
    if (wr == 1) PG8_BAR;
    PG8_WAIT_V(2); PG8_BAR;
    PG8_STAGE(PG8_SB(1, 0), cB + kstep, voffB); PG8_STAGE(PG8_SA(1, 0), cA + kstep, voffA); PG8_STAGE(PG8_SB(1, 1), cB + hstepB + kstep, voffB);
    PG8_WAIT_V(6); PG8_BAR;
    for (;;) {
        const bool has_next = S.next(ui + 1, nxt);
        const char* nA = has_next ? (const char*)g.A + (size_t)nxt.pm * tstepA : cA; const char* nB = has_next ? (const char*)g.Bt + (size_t)nxt.pn * tstepB : cB;
        for (int t = 0; t < nt; t += 2) {
            const bool last = (t == nt - 2);
            const char* a1 = cA + (size_t)(t + 1) * kstep;
            const char* a2 = last ? nA : cA + (size_t)(t + 2) * kstep; const char* b2 = last ? nB : cB + (size_t)(t + 2) * kstep;
            const char* a3 = a2 + kstep; const char* b3 = b2 + kstep;
            PG8_LDB(B0, 0, 0); PG8_LDB(B1, 0, 1); PG8_SCHED; PG8_LDA(At, 0, 0); PG8_STAGE(PG8_SA(1, 1), a1 + hstepA, voffA);
            PG8_WAIT_V(8); PG8_WAIT_L(0); PG8_BAR; PG8_MMA(0, 0, At, B0); PG8_MMA(0, 1, At, B1); PG8_BAR; PG8_SCHED;
            PG8_LDA(At, 0, 1); PG8_STAGE(PG8_SB(0, 0), b2, voffB); PG8_STAGE(PG8_SB(0, 1), b2 + hstepB, voffB); PG8_STAGE(PG8_SA(0, 0), a2, voffA);
            PG8_WAIT_V(8); PG8_WAIT_L(0); PG8_BAR; PG8_MMA(1, 0, At, B0); PG8_MMA(1, 1, At, B1); PG8_BAR; PG8_SCHED;
            PG8_LDB(B0, 1, 0); PG8_LDB(B1, 1, 1); PG8_SCHED; PG8_LDA(At, 1, 0); PG8_STAGE(PG8_SA(0, 1), a2 + hstepA, voffA);
            PG8_WAIT_V(8); PG8_WAIT_L(0); PG8_BAR; PG8_MMA(0, 0, At, B0); PG8_MMA(0, 1, At, B1); PG8_BAR; PG8_SCHED;
            PG8_LDA(At, 1, 1); PG8_STAGE(PG8_SB(1, 0), b3, voffB); PG8_STAGE(PG8_SB(1, 1), b3 + hstepB, voffB); PG8_STAGE(PG8_SA(1, 0), a3, voffA);
            PG8_WAIT_V(8); PG8_WAIT_L(0); PG8_BAR; PG8_MMA(1, 0, At, B0); PG8_MMA(1, 1, At, B1); PG8_BAR; PG8_SCHED;
        }
        if constexpr (ALIGN_EPI) { if (wr == 0) PG8_BAR; }
        E(acc, cur, wr, wc, fr, fq);
        if (!has_next) break;
        float zz1; asm volatile("v_mov_b32 %0, 0" : "=v"(zz1));
#pragma unroll
        for (int a = 0; a < 2; ++a)
#pragma unroll
            for (int b = 0; b < 2; ++b)
#pragma unroll
                for (int m = 0; m < 4; ++m)
#pragma unroll
                    for (int n = 0; n < 2; ++n) acc[a][b][m][n] = (f32x4){zz1, zz1, zz1, zz1};
        cur = nxt; cA = nA; cB = nB; ++ui;
        if constexpr (ALIGN_EPI) { if (wr == 1) PG8_BAR; }
    }
    PG8_WAIT_V(0);
    if constexpr (!ALIGN_EPI) { if (wr == 0) PG8_BAR; }
    PG8_BAR;
#undef PG8_SA
#undef PG8_SB
#undef PG8_STAGE
#undef PG8_LDA
#undef PG8_LDB
#undef PG8_MMA
#undef PG8_WAIT_V
#undef PG8_WAIT_L
#undef PG8_BAR
#undef PG8_SCHED
}
}

namespace att {
constexpr int QBLK = 32, KVBLK = 64;
constexpr int SHM_V = 16384, SHM_K = 16384, SHM_KR = 8192;
constexpr int OFF_K = 0, OFF_KRL = OFF_K + 3 * SHM_K, OFF_V = OFF_KRL + 3 * SHM_KR, OFF_WSF = OFF_V + 3 * SHM_V, OFF_BT = OFF_WSF + 8 * 64 * 4, LDS_END = OFF_BT + 4 * 768 * 4;
constexpr float THR = 8.f, LOG2E = 1.4426950408889634f;
constexpr float SC_MLA = 0.07216878364870322f  , SC_SWA = 0.08838834764831845f  ;
#define KSWZ(row, colB) ((row) * 256 + ((colB) ^ (((row) & 7) << 4)))
#define KRSWZ(row, colB) ((row) * 128 + ((colB) ^ (((row) & 7) << 4)))
#define SBAR() __builtin_amdgcn_sched_barrier(0)
__device__ __forceinline__ int crow(int r, int hi) { return (r & 3) + 8 * (r >> 2) + 4 * hi; }

template <bool MLA>
__device__ __forceinline__ void partialSM(f32x16& p0, f32x16& p1, float& m_reg, float& mn, float& alpha) {
    constexpr float SCL = MLA ? SC_MLA : 1.f, C = SCL * LOG2E;
    float pmax = p0[0];
#pragma unroll
    for (int r = 1; r < 16; ++r) pmax = fmaxf(pmax, p0[r]);
#pragma unroll
    for (int r = 0; r < 16; ++r) pmax = fmaxf(pmax, p1[r]);
    { auto rr = __builtin_amdgcn_permlane32_swap(__float_as_uint(pmax), __float_as_uint(pmax), false, false);
      pmax = fmaxf(__uint_as_float(rr[0]), __uint_as_float(rr[1])); }
    if (__builtin_expect(__all(pmax - m_reg <= THR / SCL), 1)) { mn = m_reg; alpha = 1.f; }
    else { mn = fmaxf(m_reg, pmax); alpha = __builtin_amdgcn_exp2f((m_reg - mn) * C); m_reg = mn; }
    const float mnC = -mn * C;
#pragma unroll
    for (int r = 0; r < 16; ++r) p0[r] = fmaf(p0[r], C, mnC);
#pragma unroll
    for (int r = 0; r < 16; ++r) p1[r] = fmaf(p1[r], C, mnC);
#pragma unroll
    for (int r = 0; r < 16; ++r) p0[r] = __builtin_amdgcn_exp2f(p0[r]);
}
template <bool FIRST>
__device__ __forceinline__ void partialSM_mla(f32x16& p0, f32x16& p1, float& m_reg, f32x16& negm, float& alpha) {
    constexpr float THRL = THR * LOG2E;
    float pmax = p0[0];
#pragma unroll
    for (int r = 1; r < 16; ++r) pmax = fmaxf(pmax, p0[r]);
#pragma unroll
    for (int r = 0; r < 16; ++r) pmax = fmaxf(pmax, p1[r]);
    { auto rr = __builtin_amdgcn_permlane32_swap(__float_as_uint(pmax), __float_as_uint(pmax), false, false);
      pmax = fmaxf(__uint_as_float(rr[0]), __uint_as_float(rr[1])); }
    if (!FIRST && __builtin_expect(__all(pmax <= THRL), 1)) { alpha = 1.f; }
    else { const float dl = FIRST ? pmax : fmaxf(pmax, 0.f); m_reg += dl; alpha = FIRST ? 1.f : __builtin_amdgcn_exp2f(-dl);
#pragma unroll
        for (int r = 0; r < 16; ++r) { p0[r] -= dl; p1[r] -= dl; }
#pragma unroll
        for (int r = 0; r < 16; ++r) negm[r] = -m_reg;
        asm volatile("" : "+v"(negm)); }
#pragma unroll
    for (int r = 0; r < 16; ++r) p0[r] = __builtin_amdgcn_exp2f(p0[r]);
}
__device__ __forceinline__ void finishSM(f32x16& p0, f32x16& p1, float alpha, float& l_reg, bf16x8& pa0, bf16x8& pa1, bf16x8& pa2, bf16x8& pa3) {
#pragma unroll
    for (int r = 0; r < 16; ++r) p1[r] = __builtin_amdgcn_exp2f(p1[r]);
    float ps = 0;
#pragma unroll
    for (int r = 0; r < 16; ++r) ps += p0[r];
#pragma unroll
    for (int r = 0; r < 16; ++r) ps += p1[r];
    { auto rr = __builtin_amdgcn_permlane32_swap(__float_as_uint(ps), __float_as_uint(ps), false, false);
      ps = __uint_as_float(rr[0]) + __uint_as_float(rr[1]); }
    l_reg = l_reg * alpha + ps;
#define PK4(P, BASE, OUT) do { unsigned a0 = cvt_pk_bf16(P[BASE + 0], P[BASE + 1]), a1 = cvt_pk_bf16(P[BASE + 2], P[BASE + 3]);   \
    unsigned b0 = cvt_pk_bf16(P[BASE + 4], P[BASE + 5]), b1 = cvt_pk_bf16(P[BASE + 6], P[BASE + 7]);                              \
    auto r0 = __builtin_amdgcn_permlane32_swap(a0, b0, false, false); auto r1 = __builtin_amdgcn_permlane32_swap(a1, b1, false, false); \
    u32x4 w = {r0[0], r1[0], r0[1], r1[1]}; OUT = *reinterpret_cast<bf16x8*>(&w); } while (0)
    PK4(p0, 0, pa0); PK4(p0, 8, pa1); PK4(p1, 0, pa2); PK4(p1, 8, pa3);
#undef PK4
}
template <bool MLA>
__device__ __forceinline__ void qkt(f32x16& p0, f32x16& p1, const char* Ks, const char* Krs, const bf16x8* qr, int r32, int hi, const f32x16& cinit) {
    p0 = cinit; p1 = cinit;
#pragma unroll
    for (int d0 = 0; d0 < 8; ++d0) { const int cb = (d0 * 16 + hi * 8) * 2;
        const bf16x8 b0 = *reinterpret_cast<const bf16x8*>(Ks + KSWZ(r32, cb));
        const bf16x8 b1 = *reinterpret_cast<const bf16x8*>(Ks + KSWZ(32 + r32, cb));
        p0 = __builtin_amdgcn_mfma_f32_32x32x16_bf16(b0, qr[d0], p0, 0, 0, 0);
        p1 = __builtin_amdgcn_mfma_f32_32x32x16_bf16(b1, qr[d0], p1, 0, 0, 0); }
    if constexpr (MLA) {
#pragma unroll
        for (int d0 = 0; d0 < 4; ++d0) { const int cb = (d0 * 16 + hi * 8) * 2;
            const bf16x8 b0 = *reinterpret_cast<const bf16x8*>(Krs + KRSWZ(r32, cb));
            const bf16x8 b1 = *reinterpret_cast<const bf16x8*>(Krs + KRSWZ(32 + r32, cb));
            p0 = __builtin_amdgcn_mfma_f32_32x32x16_bf16(b0, qr[8 + d0], p0, 0, 0, 0);
            p1 = __builtin_amdgcn_mfma_f32_32x32x16_bf16(b1, qr[8 + d0], p1, 0, 0, 0); }
    }
}
#define PK4(P, BASE, OUT) do { unsigned a0 = cvt_pk_bf16(P[BASE + 0], P[BASE + 1]), a1 = cvt_pk_bf16(P[BASE + 2], P[BASE + 3]);   \
    unsigned b0_ = cvt_pk_bf16(P[BASE + 4], P[BASE + 5]), b1_ = cvt_pk_bf16(P[BASE + 6], P[BASE + 7]);                              \
    auto r0 = __builtin_amdgcn_permlane32_swap(a0, b0_, false, false); auto r1 = __builtin_amdgcn_permlane32_swap(a1, b1_, false, false); \
    u32x4 w = {r0[0], r1[0], r0[1], r1[1]}; OUT = *reinterpret_cast<bf16x8*>(&w); } while (0)
#define LFIN() do { auto rr = __builtin_amdgcn_permlane32_swap(__float_as_uint(ps), __float_as_uint(ps), false, false); \
    ps = __uint_as_float(rr[0]) + __uint_as_float(rr[1]); l_reg = l_reg * alpha + ps; } while (0)
__device__ __forceinline__ void pack_p0(const f32x16& p0, bf16x8& pa0, bf16x8& pa1, float& ps0) {
    float a = 0.f;
#pragma unroll
    for (int r = 0; r < 16; ++r) a += p0[r];
    ps0 = a; PK4(p0, 0, pa0); PK4(p0, 8, pa1);
}
__device__ __forceinline__ void fin_p1(f32x16& p1, float alpha, float& l_reg, float ps0, bf16x8& pa2, bf16x8& pa3) {
    float ps = ps0;
#pragma unroll
    for (int r = 0; r < 16; ++r) { p1[r] = __builtin_amdgcn_exp2f(p1[r]); ps += p1[r]; }
    LFIN(); PK4(p1, 0, pa2); PK4(p1, 8, pa3);
}
template <bool MLA>
__device__ __forceinline__ void qkt_fin(f32x16& n0, f32x16& n1, const char* Ks, const char* Krs, const bf16x8* qr, int r32, int hi, const f32x16& cinit,
                                        f32x16& p1, float alpha, float& l_reg, float ps0, bf16x8& pa2, bf16x8& pa3) {
    constexpr int NSTEP = MLA ? 12 : 8;
    float ps = ps0;
#pragma unroll
    for (int s_ = 0; s_ < NSTEP; ++s_) {
        const bool rope = s_ >= 8; const int d0 = rope ? s_ - 8 : s_; const int cb = (d0 * 16 + hi * 8) * 2;
        const bf16x8 b0 = rope ? *reinterpret_cast<const bf16x8*>(Krs + KRSWZ(r32, cb)) : *reinterpret_cast<const bf16x8*>(Ks + KSWZ(r32, cb));
        const bf16x8 b1 = rope ? *reinterpret_cast<const bf16x8*>(Krs + KRSWZ(32 + r32, cb)) : *reinterpret_cast<const bf16x8*>(Ks + KSWZ(32 + r32, cb));
        if (s_ == 0) { n0 = __builtin_amdgcn_mfma_f32_32x32x16_bf16(b0, qr[0], cinit, 0, 0, 0); n1 = __builtin_amdgcn_mfma_f32_32x32x16_bf16(b1, qr[0], cinit, 0, 0, 0); }
        else { n0 = __builtin_amdgcn_mfma_f32_32x32x16_bf16(b0, qr[s_], n0, 0, 0, 0); n1 = __builtin_amdgcn_mfma_f32_32x32x16_bf16(b1, qr[s_], n1, 0, 0, 0); }
        if (s_ < 8) { p1[2 * s_] = __builtin_amdgcn_exp2f(p1[2 * s_]); p1[2 * s_ + 1] = __builtin_amdgcn_exp2f(p1[2 * s_ + 1]); ps += p1[2 * s_] + p1[2 * s_ + 1]; }
        if (s_ == 4) PK4(p1, 0, pa2);
        if (MLA && s_ == 8) { LFIN(); PK4(p1, 8, pa3); }
        SBAR();
    }
    if (!MLA) { LFIN(); PK4(p1, 8, pa3); }
}
#undef PK4
#undef LFIN
__device__ __forceinline__ int v_st(int k, int c) { const int kk = (k & ~0xC) | ((k & 4) << 1) | ((k & 8) >> 1); return ((kk >> 3) * 4 + (c >> 5)) * 512 + ((kk & 7) * 32 + (c & 31)) * 2; }
__device__ __forceinline__ int v_rd_base(int lane) { return ((lane & 3) << 3) | (((lane >> 2) & 3) << 6) | (((lane >> 4) & 1) << 5) | (((lane >> 5) & 1) << 8); }
constexpr int v_rd_off(int d0, int ks, int half) { return d0 * 512 + ks * 4096 + half * 2048; }
template <int OFF> __device__ __forceinline__ s16x4 tr_read(int vb) {
    s16x4 r; asm volatile("ds_read_b64_tr_b16 %0, %1 offset:%2" : "=&v"(r) : "v"(vb), "i"(OFF) : "memory"); return r;
}
template <int KS> __device__ __forceinline__ void pv_ks(f32x16* o, int vb, bf16x8 pa) {
    const s16x4 l0 = tr_read<v_rd_off(0, KS, 0)>(vb), h0 = tr_read<v_rd_off(0, KS, 1)>(vb), l1 = tr_read<v_rd_off(1, KS, 0)>(vb), h1 = tr_read<v_rd_off(1, KS, 1)>(vb);
    const s16x4 l2 = tr_read<v_rd_off(2, KS, 0)>(vb), h2 = tr_read<v_rd_off(2, KS, 1)>(vb), l3 = tr_read<v_rd_off(3, KS, 0)>(vb), h3 = tr_read<v_rd_off(3, KS, 1)>(vb);
    asm volatile("s_waitcnt lgkmcnt(0)" ::: "memory"); SBAR();
#define PK(L, H) (bf16x8){L[0], L[1], L[2], L[3], H[0], H[1], H[2], H[3]}
    o[0] = __builtin_amdgcn_mfma_f32_32x32x16_bf16(pa, PK(l0, h0), o[0], 0, 0, 0);
    o[1] = __builtin_amdgcn_mfma_f32_32x32x16_bf16(pa, PK(l1, h1), o[1], 0, 0, 0);
    o[2] = __builtin_amdgcn_mfma_f32_32x32x16_bf16(pa, PK(l2, h2), o[2], 0, 0, 0);
    o[3] = __builtin_amdgcn_mfma_f32_32x32x16_bf16(pa, PK(l3, h3), o[3], 0, 0, 0);
#undef PK
}
__device__ __forceinline__ void pv_d0(f32x16* o, int vb, bf16x8 pa0, bf16x8 pa1, bf16x8 pa2, bf16x8 pa3) {
    pv_ks<0>(o, vb, pa0); pv_ks<1>(o, vb, pa1); pv_ks<2>(o, vb, pa2); pv_ks<3>(o, vb, pa3);
}
__device__ __forceinline__ void swa_fix(f32x16& p0, f32x16& p1, const float* bt, int relb, int hi) {
    const float* bp = bt + (relb + 384 + 4 * hi);
#pragma unroll
    for (int r = 0; r < 16; ++r) { const int c = (r & 3) + 8 * (r >> 2); p0[r] = fmaf(p0[r], SC_SWA, bp[c]); p1[r] = fmaf(p1[r], SC_SWA, bp[c + 32]); }
}

template <bool MLA, int ldq, int ldk, int ldo, bool GQA4 = false>
__device__ __forceinline__ void attn_unit(const bf16_t* Qb, const bf16_t* Kh, const bf16_t* Vh, const bf16_t* Krh,
                                          bf16_t* Ob, const int NT, char* lds, const int rel0, const float sink, const int wave_s, const bool skip_last = false) {
    constexpr int NQ = MLA ? 12 : 8;
    int tid_ = tid_now(wave_s); asm volatile("" : "+v"(tid_));
    const int tid = tid_, wid = tid >> 6, lane = tid & 63, r32 = lane & 31, hi = lane >> 5;
    const int widu = __builtin_amdgcn_readfirstlane(wid);
    LAS unsigned char* ldsl = (LAS unsigned char*)lds;
    char* V_lds = lds + OFF_V; char* K_lds = lds + OFF_K; char* Kr_lds = lds + OFF_KRL;
    float* ws = (float*)(lds + OFF_WSF) + wid * 64; float* li_l = ws; float* al_l = ws + 32;
    const float* bt = (const float*)(lds + OFF_BT) + (GQA4 ? (wid >> 1) * 768 : 0);
    float m_reg = MLA ? -1e30f : sink, l_reg = MLA ? 0.f : 1.f; f32x16 o[4] = {}; bf16x8 qr[NQ];
    const bf16_t* Qw = GQA4 ? Qb + (long)((wid & 1) * QBLK + r32) * ldq + (wid >> 1) * 128 + hi * 8 : Qb + (long)(wid * QBLK + r32) * ldq + hi * 8;
#pragma unroll
    for (int d0 = 0; d0 < NQ; ++d0) qr[d0] = *(const GAS bf16x8*)(Qw + d0 * 16);
    int koff, voff, kroff;
    { const int b = wid * 1024 + lane * 16;
      { const int row = b >> 8, cB = (b & 255) ^ ((row & 7) << 4); koff = row * ldk + (cB >> 1); }
      { const int sub = b >> 9, kk = (sub >> 2) * 8 + ((b & 511) >> 6), c = (sub & 3) * 32 + ((b & 63) >> 1), k = (kk & ~0xC) | ((kk & 4) << 1) | ((kk & 8) >> 1); voff = k * ldk + c; }
      { const int row = b >> 7, cB = (b & 127) ^ ((row & 7) << 4); kroff = row * ROPE + (cB >> 1); } }
    const int vb0 = (int)(uintptr_t)V_lds + v_rd_base(lane);
    const int relq = rel0 - (GQA4 ? (wid & 1) : wid) * QBLK - r32;
#define DMA_K(t, s) do { const bf16_t* kp_ = Kh + (long)(t) * KVBLK * ldk; \
    __builtin_amdgcn_global_load_lds((const unsigned*)(kp_ + koff), (LAS unsigned*)(ldsl + OFF_K + (s) * SHM_K + widu * 1024), 16, 0, 0); \
    __builtin_amdgcn_global_load_lds((const unsigned*)(kp_ + 32 * ldk + koff), (LAS unsigned*)(ldsl + OFF_K + (s) * SHM_K + 8192 + widu * 1024), 16, 0, 0); \
    if constexpr (MLA) __builtin_amdgcn_global_load_lds((const unsigned*)(Krh + (long)(t) * KVBLK * ROPE + kroff), (LAS unsigned*)(ldsl + OFF_KRL + (s) * SHM_KR + widu * 1024), 16, 0, 0); } while (0)
#define DMA_V(t, s) do { const bf16_t* vp_ = Vh + (long)(t) * KVBLK * ldk; \
    __builtin_amdgcn_global_load_lds((const unsigned*)(vp_ + voff), (LAS unsigned*)(ldsl + OFF_V + (s) * SHM_V + widu * 1024), 16, 0, 0); \
    __builtin_amdgcn_global_load_lds((const unsigned*)(vp_ + 32 * ldk + voff), (LAS unsigned*)(ldsl + OFF_V + (s) * SHM_V + 8192 + widu * 1024), 16, 0, 0); } while (0)
#define WAITBAR_FULL() asm volatile("s_waitcnt vmcnt(0) lgkmcnt(0)\n\ts_barrier" ::: "memory")
#define WAITBAR_G1() do { if constexpr (MLA) asm volatile("s_waitcnt vmcnt(5) lgkmcnt(0)\n\ts_barrier" ::: "memory"); else asm volatile("s_waitcnt vmcnt(4) lgkmcnt(0)\n\ts_barrier" ::: "memory"); } while (0)
#define WAITBAR_G2() do { if constexpr (MLA) asm volatile("s_waitcnt vmcnt(10) lgkmcnt(0)\n\ts_barrier" ::: "memory"); else asm volatile("s_waitcnt vmcnt(8) lgkmcnt(0)\n\ts_barrier" ::: "memory"); } while (0)
#define RESC(a) do { if (__any((a) < 1.f)) { if (hi == 0) al_l[r32] = (a); asm volatile("s_waitcnt lgkmcnt(0)" ::: "memory"); \
    _Pragma("unroll") for (int d = 0; d < 4; ++d) _Pragma("unroll") for (int r = 0; r < 16; ++r) o[d][r] *= al_l[crow(r, hi)]; } } while (0)
#define FIX(P0, P1, t) do { if constexpr (!MLA) swa_fix(P0, P1, bt, relq + (t) * KVBLK, hi); } while (0)
#define ROT() do { sp = sc; sc = sn; sn = (sn == 2) ? 0 : sn + 1; } while (0)
    f32x16 pA0, pA1, pB0, pB1; float mnA, mnB, alA, alB, ps0; bf16x8 pa0, pa1, pa2, pa3;
    f32x16 negm = f32x16{}; if constexpr (MLA) { m_reg = 0.f; asm volatile("" : "+v"(negm)); }
#define PSM(P0, P1, MN, AL, FIRST) do { if constexpr (MLA) partialSM_mla<FIRST>(P0, P1, m_reg, negm, AL); else partialSM<false>(P0, P1, m_reg, MN, AL); pack_p0(P0, pa0, pa1, ps0); } while (0)
    int sp = 2, sc = 0, sn = 1;
    DMA_K(0, 0); DMA_K(1, 1); DMA_V(0, 0); DMA_K(2, 2); DMA_V(1, 1);
    WAITBAR_G2();
    qkt<MLA>(pA0, pA1, K_lds, Kr_lds, qr, r32, hi, negm); FIX(pA0, pA1, 0); PSM(pA0, pA1, mnA, alA, true);
    WAITBAR_G1();
    DMA_K(3, 0); DMA_V(2, 2);
    ROT();
    for (int j = 1; j + 1 < NT; j += 2) {
        SBAR(); qkt_fin<MLA>(pB0, pB1, K_lds + sc * SHM_K, Kr_lds + sc * SHM_KR, qr, r32, hi, negm, pA1, alA, l_reg, ps0, pa2, pa3); FIX(pB0, pB1, j); SBAR();
        pv_d0(o, vb0 + sp * SHM_V, pa0, pa1, pa2, pa3); PSM(pB0, pB1, mnB, alB, false);
        RESC(alB);
        WAITBAR_G1();
        if (j + 3 < NT) DMA_K(j + 3, sc); DMA_V(j + 2, sp);
        ROT();
        SBAR(); qkt_fin<MLA>(pA0, pA1, K_lds + sc * SHM_K, Kr_lds + sc * SHM_KR, qr, r32, hi, negm, pB1, alB, l_reg, ps0, pa2, pa3); FIX(pA0, pA1, j + 1); SBAR();
        pv_d0(o, vb0 + sp * SHM_V, pa0, pa1, pa2, pa3); PSM(pA0, pA1, mnA, alA, false);
        RESC(alA);
        if (j + 3 < NT) { WAITBAR_G1(); } else { WAITBAR_FULL(); }
        if (j + 4 < NT) DMA_K(j + 4, sc); if (j + 3 < NT) DMA_V(j + 3, sp);
        ROT();
    }
    if (GQA4 && skip_last) {
        fin_p1(pA1, alA, l_reg, ps0, pa2, pa3); SBAR();
        pv_d0(o, vb0 + sp * SHM_V, pa0, pa1, pa2, pa3);
    } else {
    SBAR(); qkt_fin<MLA>(pB0, pB1, K_lds + sc * SHM_K, Kr_lds + sc * SHM_KR, qr, r32, hi, negm, pA1, alA, l_reg, ps0, pa2, pa3); FIX(pB0, pB1, NT - 1); SBAR();
    pv_d0(o, vb0 + sp * SHM_V, pa0, pa1, pa2, pa3); PSM(pB0, pB1, mnB, alB, false);
    RESC(alB);
    fin_p1(pB1, alB, l_reg, ps0, pa2, pa3); SBAR();
    pv_d0(o, vb0 + sc * SHM_V, pa0, pa1, pa2, pa3);
    }
    if (hi == 0) li_l[r32] = l_reg; asm volatile("s_waitcnt lgkmcnt(0)" ::: "memory");
    float rli[16];
#pragma unroll
    for (int r = 0; r < 16; ++r) rli[r] = __builtin_amdgcn_rcpf(li_l[crow(r, hi)]);
    bf16_t* Ow = GQA4 ? Ob + (long)((wid & 1) * QBLK) * ldo + (wid >> 1) * 128 : Ob + (long)(wid * QBLK) * ldo;
#pragma unroll
    for (int r = 0; r < 16; ++r) { const int orow = crow(r, hi);
#pragma unroll
        for (int d0 = 0; d0 < 4; ++d0) *(GAS bf16_t*)(Ow + (long)orow * ldo + d0 * 32 + r32) = (bf16_t)(cvt_pk_bf16(o[d0][r] * rli[r], 0.f) & 0xffffu); }
    WAITBAR_FULL();
#undef DMA_K
#undef DMA_V
#undef WAITBAR_FULL
#undef WAITBAR_G1
#undef WAITBAR_G2
#undef RESC
#undef FIX
#undef ROT
#undef PSM
}
}

#define XB_TMO      128
#define XB_XCNT(j)  (256  + 64 * (j))
#define XB_XSUB(j)  (1280 + 64 * (j))
#define XB_XGEN(j)  (2304 + 64 * (j))
#define XB_TOP      3328
#define XB_TOPGEN   3392
#define XCD_BAR_WORDS 3456
#define XB_SPIN_CAP (1u << 22)
__device__ __forceinline__ unsigned xb_ld(unsigned* p)              { return __hip_atomic_load(p, __ATOMIC_RELAXED, __HIP_MEMORY_SCOPE_AGENT); }
__device__ __forceinline__ unsigned xb_add(unsigned* p, unsigned v) { return __hip_atomic_fetch_add(p, v, __ATOMIC_RELAXED, __HIP_MEMORY_SCOPE_AGENT); }
__device__ __forceinline__ unsigned xb_xcc_id() { return (unsigned)__builtin_amdgcn_s_getreg((3 << 11) | 20) & 0xFu; }
#define XB_SPIN(cond, bar) do { unsigned _sp = 0; while (cond) { __builtin_amdgcn_s_sleep(1); \
    if ((++_sp & 255u) == 0u) { if (xb_ld(&(bar)[XB_TMO])) break; if (_sp > XB_SPIN_CAP) { atomicAdd(&(bar)[XB_TMO], 1u); break; } } } } while (0)
struct XcdBarrier { unsigned* bar; unsigned x; volatile LAS unsigned* st; };
__device__ __forceinline__ XcdBarrier xcd_barrier_post(unsigned* bar, volatile LAS unsigned* st, int wave_s) {
    XcdBarrier b; b.bar = bar; b.x = xb_xcc_id(); b.st = st;
    if (tid_now(wave_s) == 0) (void)xb_add(&bar[XB_XCNT(b.x)], 1u);
    return b;
}
__device__ __forceinline__ void xcd_barrier_complete(unsigned* bar, unsigned x, unsigned& nloc, unsigned& nx) {
    const unsigned G = gridDim.x * gridDim.y * gridDim.z;
    unsigned sum, cnt, mine, sp = 0u;
    for (;;) {
        sum = 0u; cnt = 0u; mine = 0u;
#pragma unroll
        for (unsigned j = 0; j < 16; ++j) { const unsigned c = xb_ld(&bar[XB_XCNT(j)]); sum += c; cnt += (c > 0u) ? 1u : 0u; mine = (j == x) ? c : mine; }
        if (sum == G) break;
        __builtin_amdgcn_s_sleep(1);
        if ((++sp & 255u) == 0u) { if (xb_ld(&bar[XB_TMO])) break; if (sp > XB_SPIN_CAP) { atomicAdd(&bar[XB_TMO], 1u); break; } }
    }
    nloc = mine > 0u ? mine : 1u; nx = cnt > 0u ? cnt : 1u;
}
__device__ __forceinline__ void xcd_barrier(const XcdBarrier& b, int wave_s) {
    asm volatile("s_waitcnt vmcnt(0)" ::: "memory");
    __syncthreads();
    if (tid_now(wave_s) == 0) {
        unsigned* bar = b.bar;
        __builtin_amdgcn_s_waitcnt(0);
        unsigned nloc = b.st[0], nx = b.st[1];
        if (nloc == 0u) { xcd_barrier_complete(bar, b.x, nloc, nx); b.st[0] = nloc; b.st[1] = nx; }
        const unsigned old = xb_add(&bar[XB_XSUB(b.x)], 1u);
        const unsigned gen = old / nloc;
        if (old + 1u == (gen + 1u) * nloc) {
            __builtin_amdgcn_fence(__ATOMIC_RELEASE, "agent");
            asm volatile("s_waitcnt vmcnt(0)" ::: "memory");
            const unsigned og = xb_add(&bar[XB_TOP], 1u);
            const unsigned tg = og / nx;
            if (og + 1u == (tg + 1u) * nx) xb_add(&bar[XB_TOPGEN], 1u);
            else XB_SPIN(xb_ld(&bar[XB_TOPGEN]) == tg, bar);
            __builtin_amdgcn_fence(__ATOMIC_ACQUIRE, "agent");
            xb_add(&bar[XB_XGEN(b.x)], 1u);
            asm volatile("s_waitcnt vmcnt(0)" ::: "memory");
        } else {
            XB_SPIN(xb_ld(&bar[XB_XGEN(b.x)]) == gen, bar);
            __builtin_amdgcn_fence(__ATOMIC_ACQUIRE, "agent");
            asm volatile("s_waitcnt vmcnt(0)" ::: "memory");
        }
    }
    __syncthreads();
}

constexpr int NWAVES = 8;
constexpr int LDS_BYTES = 147456, LDSCTL_OFF = 147200;
static_assert(att::LDS_END <= LDSCTL_OFF && pg8::STAGE_BYTES + 1024 + 4096 <= LDSCTL_OFF && LDSCTL_OFF + 256 <= LDS_BYTES, "LDS map");

struct Args {
    const float* x; const float* p; const int* pos;
    const float* attn_norm; const float* w_in; const float* cq_norm; const float* ckv_norm; const float* w_uq; const float* w_ukv;
    const float* sink; const float* t5; const float* mla_on; const float* swa_on; const float* w_o; const float* ffn_norm;
    const float* w_gate; const float* w_up; const float* conv_w; const float* conv_b; const float* w_down;
    const float* pg_w; const float* pg_b; const float* pp_w; const float* final_norm;
    float* out; unsigned char* ws; int ph_lo, ph_hi;
};

template <int MODE>
__device__ __forceinline__ void transpose_item(const float* W, int K, int N, bf16_t* WT, int row_off, const float* kscale, LAS float* scr, int item, int lane) {
    const int nblk = N / 32, kb = item / nblk, nb = item % nblk, k0 = 64 * kb, n0 = 32 * nb;
    float tv[32];
#pragma unroll
    for (int i = 0; i < 32; ++i) { const int kk = 2 * i + (lane >> 5); tv[i] = *(const GAS float*)(W + (size_t)(k0 + kk) * N + n0 + (lane & 31)); }
#pragma unroll
    for (int i = 0; i < 32; ++i) { const int kk = 2 * i + (lane >> 5); float v = tv[i]; if (kscale) v *= kscale[k0 + kk]; scr[kk * 33 + (lane & 31)] = v; }
    asm volatile("s_waitcnt lgkmcnt(0)" ::: "memory");
    const int c = lane & 7;
#pragma unroll
    for (int j = 0; j < 4; ++j) { const int n = (lane >> 3) + 8 * j; const LAS float* s = scr + (8 * c) * 33 + n;
        u32x4 o; o.x = cvt_pk_bf16(s[0 * 33], s[1 * 33]); o.y = cvt_pk_bf16(s[2 * 33], s[3 * 33]); o.z = cvt_pk_bf16(s[4 * 33], s[5 * 33]); o.w = cvt_pk_bf16(s[6 * 33], s[7 * 33]);
        int nn = n0 + n;
        if (MODE == 1) { const int h = nn / 192, d = nn % 192; if (d >= 128) { const int e = d - 128; nn = h * 192 + 128 + 2 * (e & 31) + (e >> 5); } }
        if (MODE == 2) nn = (nn >> 7) * 256 + (nn & 127);
        *(GAS u32x4*)(WT + (size_t)(row_off + nn) * K + k0 + 8 * c) = o; }
    asm volatile("s_waitcnt lgkmcnt(0)" ::: "memory");
}

__device__ __forceinline__ int t5_bucket(int rel) {
    const int ret = rel > 0 ? 16 : 0; const int n = rel < 0 ? -rel : rel;
    if (n < 8) return ret + n;
    int large = 33 - __clz(n * n); if (large > 15) large = 15;
    return ret + large;
}

__global__ void __launch_bounds__(NWAVES * 64, 2) mk_fwd(Args a) {
    extern __shared__ __attribute__((aligned(16))) unsigned char lds[];
    cg::grid_group grid = cg::this_grid();
    const int G = gridDim.x, bx = blockIdx.x;
    const int vcu = (G % 8 == 0) ? (bx % 8) * (G / 8) + bx / 8 : bx;
    const int NGW = G * NWAVES;
    const int wave_s = __builtin_amdgcn_readfirstlane((int)threadIdx.x >> 6);
    { volatile LAS unsigned* ctl = (volatile LAS unsigned*)((LAS unsigned char*)lds + LDSCTL_OFF); const int t0 = tid_now(wave_s); if (t0 < 16) ctl[t0] = 0u; }
    __syncthreads();
    const XcdBarrier xbar = xcd_barrier_post((unsigned*)(a.ws + WS_BAR), (volatile LAS unsigned*)((LAS unsigned char*)lds + LDSCTL_OFF) + 8, wave_s);
    bool first_seam = true;
#define PHASE_IDS() int tid_ = tid_now(wave_s); asm volatile("" : "+v"(tid_)); const int tid = tid_, lane = tid & 63, wave = __builtin_amdgcn_readfirstlane(tid >> 6), gw = vcu * NWAVES + wave; (void)tid; (void)lane; (void)gw
    for (int ph2 = a.ph_lo * 2; ph2 < a.ph_hi * 2; ++ph2) {
        const int ph = ph2 >> 1;
        if (MK_DUP < 0 && (ph2 & 1)) continue;
        if (MK_DUP >= 0 && (ph2 & 1) && (ph % NPH_LAYER != MK_DUP || ph == NPHASE - 1)) continue;
        if (ph != NPHASE - 1 && ph % NPH_LAYER == 7) continue;
        if (ph2 > a.ph_lo * 2) { if (first_seam) { grid.sync(); first_seam = false; } else xcd_barrier(xbar, wave_s); }
    unsigned char* ws = a.ws; asm volatile("" : "+s"(ws));
    u64_t* ssq0 = (u64_t*)(ws + WS_SSQ0); u64_t* ssq1 = (u64_t*)(ws + WS_SSQ1); bf16_t* XB0 = (bf16_t*)(ws + WS_XB0); bf16_t* XB1 = (bf16_t*)(ws + WS_XB1);
    float* rsq = (float*)(ws + WS_RSQ); float* rskv = (float*)(ws + WS_RSKV); float* cst = (float*)(ws + WS_COS); float* snt = (float*)(ws + WS_SIN);
    bf16_t* KR = (bf16_t*)(ws + WS_KR); bf16_t* PB = (bf16_t*)(ws + WS_PB);
    bf16_t* Win_t = (bf16_t*)(ws + W_IN); bf16_t* Wuq_t = (bf16_t*)(ws + W_UQ); bf16_t* Wukv_t = (bf16_t*)(ws + W_UKV); bf16_t* Wo_t = (bf16_t*)(ws + W_O);
    bf16_t* Wgu_t = (bf16_t*)(ws + W_GU); bf16_t* Wd_t = (bf16_t*)(ws + W_D); bf16_t* Wpg_t = (bf16_t*)(ws + W_PG); bf16_t* Wpp_t = (bf16_t*)(ws + W_PP);
    bf16_t* H = (bf16_t*)(ws + WS_H); bf16_t* Z = (bf16_t*)(ws + WS_Z); bf16_t* Q = (bf16_t*)(ws + WS_Q); bf16_t* KV = (bf16_t*)(ws + WS_KV);
    bf16_t* ACT = (bf16_t*)(ws + WS_ACT); bf16_t* SBG = (bf16_t*)(ws + WS_SBG); bf16_t* SBU = (bf16_t*)(ws + WS_SBU); bf16_t* PG = (bf16_t*)(ws + WS_PG);
    LAS unsigned char* ldsl = (LAS unsigned char*)lds;

        const int L = ph / NPH_LAYER, q = (ph == NPHASE - 1) ? 99 : ph % NPH_LAYER;
        const float* xin = (L == 0) ? a.x : a.out;
        if (q == 0 && EN(0)) {
            PHASE_IDS();
            LAS float* scr = (LAS float*)(ldsl + wave * 16384);
            constexpr int I_IN = (DM / 64) * (INW / 32), I_UQ = (QRANK / 64) * (QW / 32), I_UKV = (KVRANK / 64) * (KVW / 32), I_O = (DM / 64) * (DM / 32),
                          I_G = (DM / 64) * (FF / 32), I_D = (FF / 64) * (DM / 32), I_PG = I_O, I_PP = (PLE / 64) * (DM / 32);
            constexpr int NITEMS = I_IN + I_UQ + I_UKV + I_O + 2 * I_G + I_D + I_PG + I_PP;
            for (int it = gw; it < NITEMS; it += NGW) {
                int r = it;
                if (r < I_IN) { transpose_item<0>(a.w_in + (size_t)L * DM * INW, DM, INW, Win_t, 0, a.attn_norm + L * DM, scr, r, lane); continue; } r -= I_IN;
                if (r < I_UQ) { transpose_item<1>(a.w_uq + (size_t)L * QRANK * QW, QRANK, QW, Wuq_t, 0, a.cq_norm + L * QRANK, scr, r, lane); continue; } r -= I_UQ;
                if (r < I_UKV) { transpose_item<0>(a.w_ukv + (size_t)L * KVRANK * KVW, KVRANK, KVW, Wukv_t, 0, a.ckv_norm + L * KVRANK, scr, r, lane); continue; } r -= I_UKV;
                if (r < I_O) { transpose_item<0>(a.w_o + (size_t)L * DM * DM, DM, DM, Wo_t, 0, nullptr, scr, r, lane); continue; } r -= I_O;
                if (r < I_G) { transpose_item<2>(a.w_gate + (size_t)L * DM * FF, DM, FF, Wgu_t, 0, a.ffn_norm + L * DM, scr, r, lane); continue; } r -= I_G;
                if (r < I_G) { transpose_item<2>(a.w_up + (size_t)L * DM * FF, DM, FF, Wgu_t, 128, a.ffn_norm + L * DM, scr, r, lane); continue; } r -= I_G;
                if (r < I_D) { transpose_item<0>(a.w_down + (size_t)L * FF * DM, FF, DM, Wd_t, 0, nullptr, scr, r, lane); continue; } r -= I_D;
                if (r < I_PG) { transpose_item<0>(a.pg_w + (size_t)L * DM * DM, DM, DM, Wpg_t, 0, nullptr, scr, r, lane); continue; } r -= I_PG;
                transpose_item<0>(a.pp_w + (size_t)L * PLE * DM, PLE, DM, Wpp_t, 0, nullptr, scr, r, lane);
            }
            { const unsigned z0 = opaque_zero(); const u32x4 zv = {z0, z0, z0, z0};
              for (int i = gw * 64 + lane; i < (ZW - INW) * DM / 8; i += NGW * 64) *(u32x4*)(Win_t + (size_t)INW * DM + (size_t)i * 8) = zv; }
            { const float* pl = a.p + (size_t)L * T * PLE;
              for (size_t i = (size_t)gw * 64 + lane; i < (size_t)T * PLE / 8; i += (size_t)NGW * 64) { const f32x4 v0 = *(const f32x4*)(pl + i * 8), v1 = *(const f32x4*)(pl + i * 8 + 4);
                  u32x4 w; w.x = cvt_pk_bf16(v0[0], v0[1]); w.y = cvt_pk_bf16(v0[2], v0[3]); w.z = cvt_pk_bf16(v1[0], v1[1]); w.w = cvt_pk_bf16(v1[2], v1[3]); *(u32x4*)(PB + i * 8) = w; } }
        }
        if (q == 0 && L == 0 && EN(7)) {
            PHASE_IDS();
            for (int m = gw; m < T; m += NGW) { const GAS f32x4* xr = (const GAS f32x4*)(a.x + (size_t)m * DM) + lane; f32x4 v[8]; float sm = 0.f;
#pragma unroll
                for (int j = 0; j < 8; ++j) { v[j] = xr[64 * j]; sm += (v[j].x * v[j].x + v[j].y * v[j].y) + (v[j].z * v[j].z + v[j].w * v[j].w); }
                sm = wave_sum(sm, lane); if (lane == 0) ssq0[m] = (u64_t)(sm * SSQ_FX + 0.5f);
                GAS u32x2* o8 = (GAS u32x2*)(XB0 + (size_t)m * DM) + lane;
#pragma unroll
                for (int j = 0; j < 8; ++j) { u32x2 w; w.x = cvt_pk_bf16(v[j].x, v[j].y); w.y = cvt_pk_bf16(v[j].z, v[j].w); o8[64 * j] = w; } }
        }
        if (q == 0) { }
        else if (q == 1 && EN(1)) {
            pg8::Gemm g{XB0, Win_t, T, ZW, DM, DM}; pg8::StaticOrder S; S.init(T, ZW, G, bx);
            pg8::EpiBf16 E{Z, ZW, nullptr, ssq0};
            pg8::gemm_phase<pg8::EpiBf16, true>(ldsl, g, S, E, wave_s);
        }
        else if (q == 2 && EN(2)) {
            PHASE_IDS();
            for (int m = gw; m < T; m += NGW) { const bf16_t* zr = Z + (size_t)m * ZW;
                float s1 = 0.f, s2 = 0.f;
                if (lane < 48) { const u32x4 w = *(const u32x4*)(zr + OFF_CQ + lane * 8);
#pragma unroll
                    for (int i = 0; i < 4; ++i) { const float lo = bf_lo(w[i]), hi = bf_hi(w[i]); s1 += lo * lo + hi * hi; } }
                if (lane < 32) { const u32x4 w = *(const u32x4*)(zr + OFF_CKV + lane * 8);
#pragma unroll
                    for (int i = 0; i < 4; ++i) { const float lo = bf_lo(w[i]), hi = bf_hi(w[i]); s2 += lo * lo + hi * hi; } }
                s1 = wave_sum(s1, lane); s2 = wave_sum(s2, lane);
                if (lane == 0) { rsq[m] = rsqrtf(s1 * (1.f / QRANK) + EPS); rskv[m] = rsqrtf(s2 * (1.f / KVRANK) + EPS); ssq0[m] = 0ull; ssq1[m] = 0ull; }
                if (lane < 32) { float c, s;
                    if (L == 0) { double invf = 1.0, bb = 0.7498942093324559;
#pragma unroll
                        for (int bit = 0; bit < 5; ++bit) { if ((lane >> bit) & 1) invf *= bb; bb *= bb; }
                        const double rev = (double)a.pos[m] * invf * 0.15915494309189535; const float fr = (float)(rev - rint(rev));
                        c = __builtin_amdgcn_cosf(fr); s = __builtin_amdgcn_sinf(fr); cst[(size_t)m * 32 + lane] = c; snt[(size_t)m * 32 + lane] = s; }
                    else { c = cst[(size_t)m * 32 + lane]; s = snt[(size_t)m * 32 + lane]; }
                    const float k1 = __uint_as_float((unsigned)zr[OFF_KR + lane] << 16), k2 = __uint_as_float((unsigned)zr[OFF_KR + 32 + lane] << 16);
                    *(unsigned*)(KR + (size_t)m * ROPE + 2 * lane) = cvt_pk_bf16(k1 * c - k2 * s, k1 * s + k2 * c); } }
        }
        else if (q == 3 && EN(3)) {
            { pg8::Gemm g{Z + OFF_CQ, Wuq_t, T, QW, QRANK, ZW}; pg8::StaticOrder S; S.init(T, QW, G, bx);
              pg8::EpiQ E{Q, rsq, cst, snt};
              pg8::gemm_phase<pg8::EpiQ, true>(ldsl, g, S, E, wave_s); }
            { pg8::Gemm g{Z + OFF_CKV, Wukv_t, T, KVW, KVRANK, ZW}; pg8::StaticOrder S; S.init(T, KVW, G, bx);
              pg8::EpiBf16 E{KV, KVW, rskv, nullptr};
              pg8::gemm_phase<pg8::EpiBf16, true>(ldsl, g, S, E, wave_s); }
        }
        else if (q == 4 && EN(4)) {
            constexpr int NQB = SEQ / 256, NU = BATCH * NH * NQB;
            for (int u = vcu; u < NU; u += G) { const int bh = u / NQB, qb = u % NQB, b = bh / NH, h = bh % NH; const size_t row0 = (size_t)b * SEQ;
                att::attn_unit<true, QW, KVW, DM>(Q + (row0 + (size_t)qb * 256) * QW + h * 192, KV + row0 * KVW + h * 256, KV + row0 * KVW + h * 256 + 128, KR + row0 * ROPE,
                                        H + (row0 + (size_t)qb * 256) * DM + h * 128, SEQ / 64, (char*)lds, 0, 0.f, wave_s); }
            for (int u = vcu; u < NU; u += G) { PHASE_IDS(); const int bk = u >> 8, qb64 = u & 255, b = bk >> 1, kvh = bk & 1; const size_t row0 = (size_t)b * SEQ;
                const int q0 = qb64 * 64; int key0 = q0 >= 128 ? q0 - 128 : 0; if (key0 > SEQ - 384) key0 = SEQ - 384;
                for (int i = tid; i < 4 * 768; i += NWAVES * 64) { const int hh = i / 768, rel = (i - hh * 768) - 384; ((float*)(lds + att::OFF_BT))[i] = (rel >= -128 && rel <= 128) ? a.t5[t5_bucket(rel) * NH + kvh * 4 + hh] : -1e30f; }
                __syncthreads();
                att::attn_unit<false, ZW, ZW, DM, true>(Z + (row0 + q0) * ZW + OFF_SQ + kvh * 512, Z + (row0 + key0) * ZW + OFF_SK + kvh * 128, Z + (row0 + key0) * ZW + OFF_SV + kvh * 128, nullptr,
                                         H + (row0 + q0) * DM + 1024 + kvh * 512, 6, (char*)lds, key0 - q0, a.sink[L * NH + kvh * 4 + (wave_s >> 1)], wave_s,
                                           ((q0 + 192 < SEQ ? q0 + 192 : SEQ) <= key0 + 320)); }
        }
        else if (q == 5 && EN(5)) {
            PHASE_IDS();
            f32x4 gv[4][2];
#pragma unroll
            for (int j = 0; j < 4; ++j) { const int col = (lane + 64 * j) * 8; const float* gs = (col < 1024) ? a.mla_on + L * 1024 + col : a.swa_on + L * 1024 + (col - 1024);
                gv[j][0] = *(const f32x4*)gs; gv[j][1] = *(const f32x4*)(gs + 4); }
            for (int m = gw; m < T; m += NGW) { u32x4* hr = (u32x4*)(H + (size_t)m * DM) + lane; u32x4 w[4]; float s1 = 0.f, s2 = 0.f;
#pragma unroll
                for (int j = 0; j < 4; ++j) { w[j] = hr[64 * j]; float s = 0.f;
#pragma unroll
                    for (int i = 0; i < 4; ++i) { const float lo = bf_lo(w[j][i]), hi = bf_hi(w[j][i]); s += lo * lo + hi * hi; }
                    if (j < 2) s1 += s; else s2 += s; }
                s1 = wave_sum(s1, lane); s2 = wave_sum(s2, lane);
                const float r1 = rsqrtf(s1 * (1.f / 1024) + EPS), r2 = rsqrtf(s2 * (1.f / 1024) + EPS);
#pragma unroll
                for (int j = 0; j < 4; ++j) { const float rr = j < 2 ? r1 : r2; u32x4 o;
#pragma unroll
                    for (int i = 0; i < 4; ++i) { const float g0 = (i < 2) ? gv[j][0][2 * i] : gv[j][1][2 * i - 4], g1 = (i < 2) ? gv[j][0][2 * i + 1] : gv[j][1][2 * i - 3];
                        o[i] = cvt_pk_bf16(bf_lo(w[j][i]) * rr * g0, bf_hi(w[j][i]) * rr * g1); }
                    hr[64 * j] = o; } }
        }
        else if (q == 6 && EN(6)) {
            pg8::Gemm g{H, Wo_t, T, DM, DM, DM}; pg8::StaticOrder S; S.init(T, DM, G, bx);
            pg8::EpiRes E{a.x, (L == 0) ? nullptr : XB0, nullptr, XB1, ssq1};
            pg8::gemm_phase<pg8::EpiRes, true>(ldsl, g, S, E, wave_s);
        }
        else if (q == 8 && EN(8)) {
            pg8::Gemm g{XB1, Wgu_t, T, GUW, DM, DM}; pg8::StaticOrder S; S.init(T, GUW, G, bx);
            pg8::EpiGU E{ACT, SBG, SBU, a.conv_w + (size_t)L * 3 * FF, a.conv_b + (size_t)L * FF, (LAS float*)(ldsl + 132096), ssq1};
            pg8::gemm_phase<pg8::EpiGU, true>(ldsl, g, S, E, wave_s);
        }
        else if (q == 9 && EN(9)) {
            PHASE_IDS();
            constexpr int NCC = FF / 8, NIT = (T / 256) * 2 * NCC; const float* cw = a.conv_w + (size_t)L * 3 * FF; const float* cb = a.conv_b + (size_t)L * FF;
            for (int it = gw * 64 + lane; it < NIT; it += NGW * 64) { const int cc = it % NCC, rw = it / NCC, pm = rw >> 1, which = rw & 1, f0 = cc * 8;
                const size_t R = (size_t)pm * 256 + (which ? 255 : 0); const int sq = (int)(R % SEQ);
                const unsigned z0 = opaque_zero(); const u32x4 zv = {z0, z0, z0, z0};
                u32x4 gp, gc, gn, uu;
                if (which == 0) { gp = (sq == 0) ? zv : *(const GAS u32x4*)(SBG + ((size_t)(pm - 1) * 4 + 3) * FF + f0); gc = *(const GAS u32x4*)(SBG + ((size_t)pm * 4 + 0) * FF + f0); gn = *(const GAS u32x4*)(SBG + ((size_t)pm * 4 + 1) * FF + f0); }
                else { gp = *(const GAS u32x4*)(SBG + ((size_t)pm * 4 + 2) * FF + f0); gc = *(const GAS u32x4*)(SBG + ((size_t)pm * 4 + 3) * FF + f0); gn = (sq == SEQ - 1) ? zv : *(const GAS u32x4*)(SBG + ((size_t)(pm + 1) * 4 + 0) * FF + f0); }
                uu = *(const GAS u32x4*)(SBU + ((size_t)pm * 2 + which) * FF + f0); u32x4 o;
#pragma unroll
                for (int i = 0; i < 4; ++i) { const int f = f0 + 2 * i;
                    const float ga = bf_lo(gp[i]) * cw[f] + bf_lo(gc[i]) * cw[FF + f] + bf_lo(gn[i]) * cw[2 * FF + f] + cb[f];
                    const float gb = bf_hi(gp[i]) * cw[f + 1] + bf_hi(gc[i]) * cw[FF + f + 1] + bf_hi(gn[i]) * cw[2 * FF + f + 1] + cb[f + 1];
                    const float sa = ga * __builtin_amdgcn_rcpf(1.f + __expf(-ga)), sb = gb * __builtin_amdgcn_rcpf(1.f + __expf(-gb));
                    o[i] = cvt_pk_bf16(sa * bf_lo(uu[i]), sb * bf_hi(uu[i])); }
                *(GAS u32x4*)(ACT + R * FF + f0) = o; }
        }
        else if (q == 10 && EN(10)) {
            pg8::Gemm g{ACT, Wd_t, T, DM, FF, FF}; pg8::StaticOrder S; S.init(T, DM, G, bx);
            pg8::EpiRes E{nullptr, XB1, nullptr, H, nullptr};
            pg8::gemm_phase<pg8::EpiRes, true>(ldsl, g, S, E, wave_s);
        }
        else if (q == 11 && EN(11)) {
            pg8::Gemm g{PB, Wpp_t, T, DM, PLE, PLE}; pg8::StaticOrder S; S.init(T, DM, G, bx);
            pg8::EpiBf16 E{PG, DM, nullptr, nullptr};
            pg8::gemm_phase<pg8::EpiBf16, true>(ldsl, g, S, E, wave_s);
            asm volatile("s_waitcnt vmcnt(0)" ::: "memory"); __syncthreads();
        }
        if (q == 11 && EN(12)) {
            pg8::Gemm g{H, Wpg_t, T, DM, DM, DM}; pg8::StaticOrder S; S.init(T, DM, G, bx);
            pg8::EpiPle E{H, nullptr, a.pg_b + L * DM, PG, XB0, ssq0};
            pg8::gemm_phase<pg8::EpiPle, true>(ldsl, g, S, E, wave_s);
        }
        else if (q == 99 && EN(13)) {
            PHASE_IDS();
            f32x4 gv[4][2];
#pragma unroll
            for (int j = 0; j < 4; ++j) { gv[j][0] = *(const GAS f32x4*)(a.final_norm + (lane + 64 * j) * 8); gv[j][1] = *(const GAS f32x4*)(a.final_norm + (lane + 64 * j) * 8 + 4); }
            for (int m = gw; m < T; m += NGW) { const GAS u32x4* xr = (const GAS u32x4*)(XB0 + (size_t)m * DM) + lane; u32x4 w[4];
#pragma unroll
                for (int j = 0; j < 4; ++j) w[j] = xr[64 * j];
                const float rstd = rsqrtf((float)*(const GAS u64_t*)(ssq0 + m) * (SSQ_INV / DM) + EPS);
                GAS f32x4* orow = (GAS f32x4*)(a.out + (size_t)m * DM);
#pragma unroll
                for (int j = 0; j < 4; ++j) { const f32x4 v0 = {bf_lo(w[j].x), bf_hi(w[j].x), bf_lo(w[j].y), bf_hi(w[j].y)}, v1 = {bf_lo(w[j].z), bf_hi(w[j].z), bf_lo(w[j].w), bf_hi(w[j].w)};
                    orow[(lane + 64 * j) * 2] = v0 * rstd * gv[j][0]; orow[(lane + 64 * j) * 2 + 1] = v1 * rstd * gv[j][1]; } }
        }
    }
}

extern "C" void kernel_launch(void* const* d_in, const int* in_sizes, int n_in, void* d_out, int out_size, void* d_ws, size_t ws_size, hipStream_t stream) {
    static int grid = 0;
    if (grid == 0) {
        if (n_in != 24 || out_size != T * DM || ws_size < WS_NEED) { fprintf(stderr, "kernel_launch: unexpected shapes (n_in %d out %d ws %zu need %zu)\n", n_in, out_size, ws_size, (size_t)WS_NEED); grid = -1; return; }
        int dev = 0, cus = 0, per_cu = 0;
        hipGetDevice(&dev); hipDeviceGetAttribute(&cus, hipDeviceAttributeMultiprocessorCount, dev);
        if (hipFuncSetAttribute((const void*)mk_fwd, hipFuncAttributeMaxDynamicSharedMemorySize, LDS_BYTES) != hipSuccess) { fprintf(stderr, "kernel_launch: hipFuncSetAttribute failed\n"); grid = -1; return; }
        if (hipOccupancyMaxActiveBlocksPerMultiprocessor(&per_cu, (const void*)mk_fwd, NWAVES * 64, LDS_BYTES) != hipSuccess || per_cu < 1) { fprintf(stderr, "kernel_launch: occupancy query says %d\n", per_cu); per_cu = 1; }
        (void)hipGetLastError();
        grid = cus * 1;
        fprintf(stderr, "kernel_launch: grid %d (cus %d, per_cu %d)\n", grid, cus, per_cu);
    }
    if (grid < 0) return;
    if (hipMemsetAsync((char*)d_ws + WS_BAR, 0, WS_BAR_BYTES, stream) != hipSuccess) { fprintf(stderr, "kernel_launch: memset failed\n"); return; }
    Args a{};
    a.x = (const float*)d_in[0]; a.p = (const float*)d_in[1]; a.pos = (const int*)d_in[2];
    a.attn_norm = (const float*)d_in[3]; a.w_in = (const float*)d_in[4]; a.cq_norm = (const float*)d_in[5]; a.ckv_norm = (const float*)d_in[6];
    a.w_uq = (const float*)d_in[7]; a.w_ukv = (const float*)d_in[8]; a.sink = (const float*)d_in[9]; a.t5 = (const float*)d_in[10];
    a.mla_on = (const float*)d_in[11]; a.swa_on = (const float*)d_in[12]; a.w_o = (const float*)d_in[13]; a.ffn_norm = (const float*)d_in[14];
    a.w_gate = (const float*)d_in[15]; a.w_up = (const float*)d_in[16]; a.conv_w = (const float*)d_in[17]; a.conv_b = (const float*)d_in[18]; a.w_down = (const float*)d_in[19];
    a.pg_w = (const float*)d_in[20]; a.pg_b = (const float*)d_in[21]; a.pp_w = (const float*)d_in[22]; a.final_norm = (const float*)d_in[23];
    a.out = (float*)d_out; a.ws = (unsigned char*)d_ws;
#if MK_MULTI
    for (int ph = 0; ph < NPHASE; ++ph) { a.ph_lo = ph; a.ph_hi = ph + 1; void* args[] = {&a};
        hipError_t e = hipLaunchCooperativeKernel((const void*)mk_fwd, dim3(grid), dim3(NWAVES * 64), args, LDS_BYTES, stream);
        if (e != hipSuccess) { fprintf(stderr, "kernel_launch: launch %d failed: %s\n", ph, hipGetErrorString(e)); break; } }
#else
    a.ph_lo = 0; a.ph_hi = NPHASE; void* args[] = {&a};
    hipError_t e = hipLaunchCooperativeKernel((const void*)mk_fwd, dim3(grid), dim3(NWAVES * 64), args, LDS_BYTES, stream);
    if (e != hipSuccess) fprintf(stderr, "kernel_launch: cooperative launch failed: %s (grid %d)\n", hipGetErrorString(e), grid);
#endif
}
```
